# Optimizing an MI355X kernel written in HIP

```python
import jax, jax.numpy as jnp
from jax import lax
import numpy as np

D_MODEL = 2048
BATCH = 2
SEQ = 8192
DEPTH = 4

N_MIXERS = 2
N_ATTN_LAYERS = (DEPTH + N_MIXERS - 1) // N_MIXERS
N_POOL_LAYERS = DEPTH // N_MIXERS
HEAD_DIM = 64
N_HEADS = D_MODEL // HEAD_DIM
N_KV_HEADS = N_HEADS // 8
GQA_GROUP = N_HEADS // N_KV_HEADS
WINDOW = 128
BLOCK = WINDOW
N_BUCKETS = 32
MAX_DISTANCE = 128
POOL_WINDOWS = (2, 4, 8, 16)
N_POOL_GROUPS = len(POOL_WINDOWS)
POOL_GROUP_DIM = D_MODEL // N_POOL_GROUPS
D_FF = 5632
CONV_WIDTH = 3
EPS = 1e-6
NEG_INF = -1e30

kernel_name = "hybrid_swa_sink_pool_convffn"


def rmsnorm(x, gain):
    xf = x.astype(jnp.float32)
    y = xf * lax.rsqrt(jnp.mean(xf * xf, axis=-1, keepdims=True) + EPS)
    return (y * gain.astype(jnp.float32)).astype(x.dtype)


def _t5_band_buckets():
    i = np.arange(BLOCK)[:, None]
    j = np.arange(2 * BLOCK)[None, :]
    n = np.maximum(BLOCK + i - j, 0)
    max_exact = N_BUCKETS // 2
    nf = np.maximum(n, 1).astype(np.float32)
    large = max_exact + (np.log(nf / max_exact) / np.log(MAX_DISTANCE / max_exact)
                         * (N_BUCKETS - max_exact)).astype(np.int32)
    large = np.minimum(large, N_BUCKETS - 1)
    return np.where(n < max_exact, n, large).astype(np.int32)


def _band_mask(n_blocks):
    i = np.arange(BLOCK)[:, None]
    j = np.arange(2 * BLOCK)[None, :]
    dist = BLOCK + i - j
    in_win = (dist >= 0) & (dist < WINDOW)
    key_pos = np.arange(n_blocks)[:, None, None] * BLOCK - BLOCK + j[None]
    return in_win[None] & (key_pos >= 0)


def sliding_window_attention(h, w_qkv, q_gain, k_gain, sinks, rel_bias, w_o):
    B, S, _ = h.shape
    nb = S // BLOCK
    qkv = h @ w_qkv
    q, k, v = jnp.split(qkv, [N_HEADS * HEAD_DIM, (N_HEADS + N_KV_HEADS) * HEAD_DIM], axis=-1)
    q = rmsnorm(q.reshape(B, S, N_HEADS, HEAD_DIM), q_gain)
    k = rmsnorm(k.reshape(B, S, N_KV_HEADS, HEAD_DIM), k_gain)
    v = v.reshape(B, S, N_KV_HEADS, HEAD_DIM)
    q = q.reshape(B, nb, BLOCK, N_KV_HEADS, GQA_GROUP, HEAD_DIM)

    def band(t):
        t = t.reshape(B, nb, BLOCK, N_KV_HEADS, HEAD_DIM)
        prev = jnp.pad(t[:, :-1], ((0, 0), (1, 0), (0, 0), (0, 0), (0, 0)))
        return jnp.concatenate([prev, t], axis=2)

    kb, vb = band(k), band(v)
    s = jnp.einsum('bnqkgd,bnskd->bnkgqs', q, kb).astype(jnp.float32) * (HEAD_DIM ** -0.5)
    bias = rel_bias[:, _t5_band_buckets()].astype(jnp.float32)
    bias = bias.reshape(N_KV_HEADS, GQA_GROUP, BLOCK, 2 * BLOCK)
    mask = jnp.asarray(_band_mask(nb))[None, :, None, None]
    s = jnp.where(mask, s + bias, NEG_INF)
    sink = sinks.astype(jnp.float32).reshape(N_KV_HEADS, GQA_GROUP)[:, :, None, None]
    m = jnp.maximum(jnp.max(s, axis=-1, keepdims=True), sink)
    p = jnp.exp(s - m)
    p = p / (jnp.sum(p, axis=-1, keepdims=True) + jnp.exp(sink - m))
    o = jnp.einsum('bnkgqs,bnskd->bnqkgd', p.astype(vb.dtype), vb)
    return o.reshape(B, S, N_HEADS * HEAD_DIM) @ w_o


def multiscale_pool_mixer(h, w_pool, scale):
    B, S, _ = h.shape
    hg = h.reshape(B, S, N_POOL_GROUPS, POOL_GROUP_DIM)
    hf = hg.astype(jnp.float32)
    c = jnp.cumsum(hf, axis=1)
    t = jnp.arange(S)
    means = []
    for g, w in enumerate(POOL_WINDOWS):
        cg = c[:, :, g]
        lag = jnp.pad(cg, ((0, 0), (w, 0), (0, 0)))[:, :S]
        cnt = jnp.minimum(t + 1, w).astype(jnp.float32)[None, :, None]
        means.append((cg - lag) / cnt)
    d = (jnp.stack(means, axis=2) - hf).astype(h.dtype)
    y = jnp.einsum('bsgc,gce->bsge', d, w_pool).reshape(B, S, D_MODEL)
    return y * scale


def conv_gated_mlp(h, w_up, conv_w, conv_b, w_down):
    S = h.shape[1]
    u = h @ w_up
    up = jnp.pad(u, ((0, 0), (CONV_WIDTH - 1, 0), (0, 0)))
    u = sum(conv_w[k] * up[:, k:k + S] for k in range(CONV_WIDTH)) + conv_b
    gate, val = jnp.split(u, 2, axis=-1)
    return (jax.nn.silu(gate) * val) @ w_down


def setup_inputs(seed: int = 0) -> dict:
    key = jax.random.key(seed)
    ks = jax.random.split(key, 16)
    f32 = jnp.float32
    qkv_out = (N_HEADS + 2 * N_KV_HEADS) * HEAD_DIM
    return {
        "x": jax.random.normal(ks[0], (BATCH, SEQ, D_MODEL), f32),
        "norm_mix": 1.0 + 0.05 * jax.random.normal(ks[1], (DEPTH, D_MODEL), f32),
        "norm_ffn": 1.0 + 0.05 * jax.random.normal(ks[2], (DEPTH, D_MODEL), f32),
        "rel_bias": 0.5 * jax.random.normal(ks[3], (N_HEADS, N_BUCKETS), f32),
        "attn_w_qkv": jax.random.normal(ks[4], (N_ATTN_LAYERS, D_MODEL, qkv_out), f32) * D_MODEL ** -0.5,
        "attn_q_gain": 1.0 + 0.05 * jax.random.normal(ks[5], (N_ATTN_LAYERS, HEAD_DIM), f32),
        "attn_k_gain": 1.0 + 0.05 * jax.random.normal(ks[6], (N_ATTN_LAYERS, HEAD_DIM), f32),
        "attn_sinks": 0.5 * jax.random.normal(ks[7], (N_ATTN_LAYERS, N_HEADS), f32),
        "attn_w_o": jax.random.normal(ks[8], (N_ATTN_LAYERS, N_HEADS * HEAD_DIM, D_MODEL), f32) * (N_HEADS * HEAD_DIM) ** -0.5,
        "pool_w": jax.random.normal(ks[9], (N_POOL_LAYERS, N_POOL_GROUPS, POOL_GROUP_DIM, POOL_GROUP_DIM), f32) * POOL_GROUP_DIM ** -0.5,
        "pool_scale": 1.0 + 0.05 * jax.random.normal(ks[10], (N_POOL_LAYERS, D_MODEL), f32),
        "ffn_w_up": jax.random.normal(ks[11], (DEPTH, D_MODEL, 2 * D_FF), f32) * D_MODEL ** -0.5,
        "ffn_conv_w": jax.random.normal(ks[12], (DEPTH, CONV_WIDTH, 2 * D_FF), f32) * CONV_WIDTH ** -0.5,
        "ffn_conv_b": 0.02 * jax.random.normal(ks[13], (DEPTH, 2 * D_FF), f32),
        "ffn_w_down": jax.random.normal(ks[14], (DEPTH, D_FF, D_MODEL), f32) * D_FF ** -0.5,
    }


def reference(x, norm_mix, norm_ffn, rel_bias, attn_w_qkv, attn_q_gain, attn_k_gain,
              attn_sinks, attn_w_o, pool_w, pool_scale, ffn_w_up, ffn_conv_w, ffn_conv_b,
              ffn_w_down):
    for i in range(DEPTH):
        h = rmsnorm(x, norm_mix[i])
        j = i // N_MIXERS
        if i % N_MIXERS == 0:
            mix = sliding_window_attention(h, attn_w_qkv[j], attn_q_gain[j], attn_k_gain[j],
                                           attn_sinks[j], rel_bias, attn_w_o[j])
        else:
            mix = multiscale_pool_mixer(h, pool_w[j], pool_scale[j])
        x = x + mix
        h = rmsnorm(x, norm_ffn[i])
        x = x + conv_gated_mlp(h, ffn_w_up[i], ffn_conv_w[i], ffn_conv_b[i], ffn_w_down[i])
    return x
```

```cpp
#include <hip/hip_runtime.h>
#include <hip/hip_cooperative_groups.h>
#include <cstdio>
#include <cstdint>
namespace cg = cooperative_groups;

__device__ __forceinline__ int tid_now(int wave_s) { int l; asm volatile("v_mbcnt_lo_u32_b32 %0, -1, 0\n\tv_mbcnt_hi_u32_b32 %0, -1, %0" : "=v"(l)); return (wave_s << 6) | l; }

__device__ __forceinline__ float dpp_f(float v, int) { return v; }
#define DPP_MOVF(v, ctrl) __builtin_bit_cast(float, __builtin_amdgcn_update_dpp(0, __builtin_bit_cast(int, (float)(v)), (ctrl), 0xf, 0xf, true))
__device__ __forceinline__ float sum_x1(float s) { return s + DPP_MOVF(s, 0xB1); }
__device__ __forceinline__ float sum8(float s) { s += DPP_MOVF(s, 0xB1); s += DPP_MOVF(s, 0x4E); s += DPP_MOVF(s, 0x141); return s; }
__device__ __forceinline__ float sum_x32(float t) { float a = t, b = t; asm volatile("s_nop 1\n\tv_permlane32_swap_b32 %0, %1" : "+v"(a), "+v"(b)); return a + b; }

namespace pg8 {
#define PG8_LAS __attribute__((address_space(3)))
typedef unsigned short bf16_t;
typedef short bf16x8 __attribute__((ext_vector_type(8)));
typedef float f32x4 __attribute__((ext_vector_type(4)));
typedef unsigned u32x4 __attribute__((ext_vector_type(4)));
typedef unsigned u32x2 __attribute__((ext_vector_type(2)));
constexpr int BM = 256, BK = 64, HALF = 128, HTB = HALF * BK * 2  , STAGE_BYTES = 8 * HTB, NXCD = 8, WGM = 8;

__host__ __device__ __forceinline__ int lds_byte(int r, int c) { const int st = (r >> 4) * 2 + (c >> 5), rr = r & 15, cc = c & 31, ob = rr * 64 + cc * 2; return st * 1024 + (ob ^ (((ob >> 9) & 1) << 5)); }
__host__ __device__ __forceinline__ void stage_rc(int b, int& R, int& C) { const int st = b / 1024, sb = b % 1024, swz = sb ^ (((sb >> 9) & 1) << 5); R = (st >> 1) * 16 + swz / 64; C = (st & 1) * 32 + (swz % 64) / 2; }
__host__ __device__ __forceinline__ int perm32(int rho) { const int n = rho >> 4, i = rho & 15; return 8 * (i >> 2) + 4 * n + (i & 3); }

struct Unit { int pm, pn; };
struct Gemm { const bf16_t* A; const bf16_t* Bt; int lda, ldb, K, npg; };

struct StaticOrder {
    int nM, nN, nwg, G, c;
    __host__ __device__ __forceinline__ void init(int M, int N, int G_, int c_) { nM = M / BM; nN = N / BM; nwg = nM * nN; G = G_; c = c_; }
    __host__ __device__ __forceinline__ bool next(int i, Unit& u) const {
        const long L = (long)i * G + c; if (L >= nwg) return false;
        int wgid = (int)L; { const int q = nwg / NXCD, r = nwg % NXCD, xcd = wgid % NXCD, off = wgid / NXCD; wgid = (xcd < r ? xcd * (q + 1) : r * (q + 1) + (xcd - r) * q) + off; }
        const int nig = WGM * nN, gid = wgid / nig, fm = gid * WGM, gsz = (nM - fm) < WGM ? (nM - fm) : WGM;
        u.pm = fm + ((wgid % nig) % gsz); u.pn = (wgid % nig) / gsz; return true;
    }
    __device__ __forceinline__ void a_ready(const Unit&) const {}
    __device__ __forceinline__ void done(const Unit&) const {}
};

typedef float f32x2c __attribute__((ext_vector_type(2))); typedef __bf16 bf16x2c __attribute__((ext_vector_type(2)));
__device__ __forceinline__ unsigned cvt_pk_bf16(float lo, float hi) { f32x2c v = {lo, hi}; bf16x2c b = __builtin_convertvector(v, bf16x2c); return __builtin_bit_cast(unsigned, b); }

constexpr float RMS_EPS = 1e-6f;
__device__ __forceinline__ float sum_fq(float t) {
    float a = t, b = t; asm volatile("s_nop 1\n\tv_permlane16_swap_b32 %0, %1" : "+v"(a), "+v"(b)); t = a + b;
    a = t; b = t; asm volatile("s_nop 1\n\tv_permlane32_swap_b32 %0, %1" : "+v"(a), "+v"(b)); return a + b; }
__device__ __forceinline__ float row_rstd4(const float* ss, int row, int fq) { const f32x4* p = (const f32x4*)(ss + (size_t)row * 32 + 8 * fq); const f32x4 a = p[0] + p[1];
    float t = sum_fq((a[0] + a[1]) + (a[2] + a[3]));
    return __builtin_amdgcn_rsqf(t * (1.0f / 2048.0f) + RMS_EPS); }
__device__ __forceinline__ float bf_lo(unsigned w) { return __builtin_bit_cast(float, w << 16); }
__device__ __forceinline__ float bf_hi(unsigned w) { return __builtin_bit_cast(float, w & 0xffff0000u); }
constexpr int LDS_X_OFF = 131072, LDS_RS_OFF = 131072 + 8192 + 256, LDS_CW_OFF = LDS_RS_OFF + 1024;
__device__ __forceinline__ void prep_rstd(PG8_LAS unsigned char* lds, const float* ss, int tid, int pm) {
    PG8_LAS float* RS = (PG8_LAS float*)(lds + LDS_RS_OFF);
    const int row = tid >> 1, h = tid & 1; const f32x4* p = (const f32x4*)(ss + (size_t)(pm * BM + row) * 32 + 16 * h);
    f32x4 a = p[0] + p[1]; const f32x4 b = p[2] + p[3]; a += b; float t = (a[0] + a[1]) + (a[2] + a[3]);
    t = sum_x1(t);
    if (h == 0) RS[row] = __builtin_amdgcn_rsqf(t * (1.0f / 2048.0f) + RMS_EPS);
    asm volatile("s_waitcnt lgkmcnt(0)" ::: "memory"); __syncthreads();
}
struct EpiScaleBf16 {
    static constexpr bool PERM = true, AFTER_DRAIN = false, AROW8 = false;
    bf16_t* O; int ldc; const float* ss; PG8_LAS unsigned char* lds;
    __device__ __forceinline__ void prep(int tid, const Unit& u) const { prep_rstd(lds, ss, tid, u.pm); }
    __device__ __forceinline__ void operator()(const f32x4 (&acc)[2][2][4][2], const Unit& u, int wr, int wc, int fr_, int fq_) const {
        int fr = fr_, fq = fq_; asm volatile("" : "+v"(fr), "+v"(fq));
        const int row0 = u.pm * BM + wr * 64 + fr, col0 = u.pn * BM + wc * 32 + 8 * fq;
#pragma unroll
        for (int ai = 0; ai < 2; ++ai)
#pragma unroll
            for (int m = 0; m < 4; ++m) { const int row = row0 + ai * HALF + m * 16; const float rs = ((const PG8_LAS float*)(lds + LDS_RS_OFF))[ai * HALF + wr * 64 + m * 16 + fr];
                bf16_t* rowp = O + (size_t)row * ldc + col0;
#pragma unroll
                for (int bj = 0; bj < 2; ++bj) { const f32x4 v0 = acc[ai][bj][m][0] * rs, v1 = acc[ai][bj][m][1] * rs;
                    u32x4 w; w.x = cvt_pk_bf16(v0[0], v0[1]); w.y = cvt_pk_bf16(v0[2], v0[3]); w.z = cvt_pk_bf16(v1[0], v1[1]); w.w = cvt_pk_bf16(v1[2], v1[3]);
                    *(u32x4*)(rowp + bj * HALF) = w; } }
    }
};
struct EpiResidual {
    static constexpr bool PERM = true, AFTER_DRAIN = false, AROW8 = false;
    bf16_t* xb; float* out; const float* cs; float* ssn;
    __device__ __forceinline__ void prep(int, const Unit&) const {}
    __device__ __forceinline__ void operator()(const f32x4 (&acc)[2][2][4][2], const Unit& u, int wr, int wc, int fr_, int fq_) const {
        int fr = fr_, fq = fq_; asm volatile("" : "+v"(fr), "+v"(fq));
        const int col0 = u.pn * BM + wc * 32 + 8 * fq;
        const size_t off0 = (size_t)(u.pm * BM + wr * 64 + fr) * 2048 + col0;
        u32x4 bw[2][4][2];
#pragma unroll
        for (int ai = 0; ai < 2; ++ai)
#pragma unroll
            for (int m = 0; m < 4; ++m)
#pragma unroll
                for (int bj = 0; bj < 2; ++bj) bw[ai][m][bj] = *(const u32x4*)(xb + off0 + (size_t)(ai * HALF + m * 16) * 2048 + bj * HALF);
        f32x4 cv[2][2];
#pragma unroll
        for (int bj = 0; bj < 2; ++bj)
#pragma unroll
            for (int n = 0; n < 2; ++n) cv[bj][n] = cs ? *(const f32x4*)(cs + col0 + bj * HALF + n * 4) : (f32x4){1.f, 1.f, 1.f, 1.f};
#pragma unroll
        for (int ai = 0; ai < 2; ++ai)
#pragma unroll
            for (int m = 0; m < 4; ++m) { const int row = u.pm * BM + ai * HALF + wr * 64 + m * 16 + fr; const size_t off = off0 + (size_t)(ai * HALF + m * 16) * 2048; float s = 0.f;
#pragma unroll
                for (int bj = 0; bj < 2; ++bj) { const u32x4 w0 = bw[ai][m][bj];
                    const f32x4 v0 = (f32x4){bf_lo(w0.x), bf_hi(w0.x), bf_lo(w0.y), bf_hi(w0.y)} + acc[ai][bj][m][0] * cv[bj][0];
                    const f32x4 v1 = (f32x4){bf_lo(w0.z), bf_hi(w0.z), bf_lo(w0.w), bf_hi(w0.w)} + acc[ai][bj][m][1] * cv[bj][1];
                    if (out) { *(f32x4*)(out + off + bj * HALF) = v0; *(f32x4*)(out + off + bj * HALF + 4) = v1; }
                    u32x4 w; w.x = cvt_pk_bf16(v0[0], v0[1]); w.y = cvt_pk_bf16(v0[2], v0[3]); w.z = cvt_pk_bf16(v1[0], v1[1]); w.w = cvt_pk_bf16(v1[2], v1[3]); if (!out) *(u32x4*)(xb + off + bj * HALF) = w;
                    s += ((v0[0] * v0[0] + v0[1] * v0[1]) + (v0[2] * v0[2] + v0[3] * v0[3])) + ((v1[0] * v1[0] + v1[1] * v1[1]) + (v1[2] * v1[2] + v1[3] * v1[3])); }
                if (!out) { s = sum_fq(s); if (fq == 0) ssn[(size_t)row * 32 + u.pn * 4 + wc] = s; } }
    }
};
__device__ __forceinline__ float dpp_shr1(float v, float old) { return __builtin_bit_cast(float, __builtin_amdgcn_update_dpp(__builtin_bit_cast(int, old), __builtin_bit_cast(int, v), 0x111, 0xf, 0xf, false)); }
__device__ __forceinline__ float dpp_shr2(float v, float old) { return __builtin_bit_cast(float, __builtin_amdgcn_update_dpp(__builtin_bit_cast(int, old), __builtin_bit_cast(int, v), 0x112, 0xf, 0xf, false)); }
__device__ __forceinline__ float dpp_ror1(float v) { return __builtin_bit_cast(float, __builtin_amdgcn_update_dpp(0, __builtin_bit_cast(int, v), 0x121, 0xf, 0xf, false)); }
__device__ __forceinline__ float dpp_ror2(float v) { return __builtin_bit_cast(float, __builtin_amdgcn_update_dpp(0, __builtin_bit_cast(int, v), 0x122, 0xf, 0xf, false)); }
constexpr int NUP_ = 11264, DFF_ = 5632;
struct EpiConvAct {
    static constexpr bool PERM = true, AFTER_DRAIN = false, AROW8 = true;
    bf16_t* act; const float* ss; const float* cw; const float* cb; float* hbuf; PG8_LAS unsigned char* lds;
    __device__ __forceinline__ void prep(int tid, const Unit& u) const { prep_rstd(lds, ss, tid, u.pm); }
    __device__ __forceinline__ void operator()(f32x4 (&acc)[2][2][4][2], const Unit& u, int wr, int wc, int fr_, int fq_) const {
        int fr = fr_, fq = fq_; asm volatile("" : "+v"(fr), "+v"(fq));
        PG8_LAS float* X = (PG8_LAS float*)(lds + LDS_X_OFF); const PG8_LAS float* RS = (const PG8_LAS float*)(lds + LDS_RS_OFF); PG8_LAS float* CW = (PG8_LAS float*)(lds + LDS_CW_OFF);
        typedef float f32x2w __attribute__((ext_vector_type(2)));
        const int t2 = (((wr * 4 + wc) * 64) + fq * 16 + fr) * 2, wk = t2 >> 8, wgv = (t2 >> 7) & 1, wch = t2 & 127;
        const f32x2w wld = *(const f32x2w*)((wk < 3 ? cw + wk * NUP_ : cb) + wgv * DFF_ + u.pn * HALF + wch);
        const int t0 = (wr * 16 + fr) * 8;
        { const f32x4 r0 = *(const PG8_LAS f32x4*)(RS + t0), r1 = *(const PG8_LAS f32x4*)(RS + t0 + 4);
#pragma unroll
          for (int m = 0; m < 4; ++m)
#pragma unroll
            for (int bj = 0; bj < 2; ++bj)
#pragma unroll
                for (int n = 0; n < 2; ++n) { acc[0][bj][m][n] *= r0[m]; acc[1][bj][m][n] *= r1[m]; } }
        const int colb = wc * 32 + 8 * fq;
        if (wr == 0 && fr == 15) {
#pragma unroll
            for (int bj = 0; bj < 2; ++bj)
#pragma unroll
                for (int n = 0; n < 2; ++n) { *(PG8_LAS f32x4*)(X + bj * HALF + n * 4 + colb) = acc[1][bj][2][n]; *(PG8_LAS f32x4*)(X + 256 + bj * HALF + n * 4 + colb) = acc[1][bj][3][n]; } }
        { float* hb = hbuf + (size_t)u.pm * 4 * NUP_ + u.pn * BM + colb;
          if (wr == 0 && fr == 0) {
#pragma unroll
              for (int bj = 0; bj < 2; ++bj)
#pragma unroll
                  for (int n = 0; n < 2; ++n) { *(f32x4*)(hb + bj * HALF + n * 4) = acc[0][bj][0][n]; *(f32x4*)(hb + (size_t)NUP_ + bj * HALF + n * 4) = acc[0][bj][1][n]; } }
          if (wr == 1 && fr == 15) {
#pragma unroll
              for (int bj = 0; bj < 2; ++bj)
#pragma unroll
                  for (int n = 0; n < 2; ++n) { *(f32x4*)(hb + (size_t)2 * NUP_ + bj * HALF + n * 4) = acc[1][bj][2][n]; *(f32x4*)(hb + (size_t)3 * NUP_ + bj * HALF + n * 4) = acc[1][bj][3][n]; } } }
        *(PG8_LAS f32x2w*)(CW + t2) = wld;
        asm volatile("s_waitcnt lgkmcnt(0)" ::: "memory"); __builtin_amdgcn_s_barrier(); asm volatile("" ::: "memory");
        u32x2 pk[2][8];
        const bool defer01 = (u.pm & 31) != 0 && wr == 0 && fr == 0;
#pragma unroll
        for (int n = 0; n < 2; ++n) { const int chl = wc * 32 + 8 * fq + 4 * n;
            const f32x4 wg0 = *(const PG8_LAS f32x4*)(CW + chl), wg1 = *(const PG8_LAS f32x4*)(CW + 256 + chl), wg2 = *(const PG8_LAS f32x4*)(CW + 512 + chl), bg = *(const PG8_LAS f32x4*)(CW + 768 + chl);
            const f32x4 wv0 = *(const PG8_LAS f32x4*)(CW + 128 + chl), wv1 = *(const PG8_LAS f32x4*)(CW + 384 + chl), wv2 = *(const PG8_LAS f32x4*)(CW + 640 + chl), bv = *(const PG8_LAS f32x4*)(CW + 896 + chl);
            f32x4 h6g = (f32x4){0.f, 0.f, 0.f, 0.f}, h7g = h6g, h6v = h6g, h7v = h6g;
            if (wr == 1 && fr == 0) { h6g = *(const PG8_LAS f32x4*)(X + n * 4 + colb); h7g = *(const PG8_LAS f32x4*)(X + 256 + n * 4 + colb); h6v = *(const PG8_LAS f32x4*)(X + HALF + n * 4 + colb); h7v = *(const PG8_LAS f32x4*)(X + 256 + HALF + n * 4 + colb); }
#pragma unroll
            for (int i = 0; i < 4; ++i) { h6g[i] = dpp_shr1(acc[1][0][2][n][i], h6g[i]); h7g[i] = dpp_shr1(acc[1][0][3][n][i], h7g[i]); h6v[i] = dpp_shr1(acc[1][1][2][n][i], h6v[i]); h7v[i] = dpp_shr1(acc[1][1][3][n][i], h7v[i]); }
            f32x4 g2 = h6g, g1 = h7g, v2 = h6v, v1 = h7v;
#pragma unroll
            for (int j = 0; j < 8; ++j) { const f32x4 Gc = acc[j >> 2][0][j & 3][n], Vc = acc[j >> 2][1][j & 3][n];
                const f32x4 gc = wg0 * g2 + wg1 * g1 + wg2 * Gc + bg, vc = wv0 * v2 + wv1 * v1 + wv2 * Vc + bv; f32x4 o;
#pragma unroll
                for (int i = 0; i < 4; ++i) o[i] = gc[i] * __builtin_amdgcn_rcpf(1.0f + __builtin_amdgcn_exp2f(gc[i] * -1.4426950408889634f)) * vc[i];
                pk[n][j].x = cvt_pk_bf16(o[0], o[1]); pk[n][j].y = cvt_pk_bf16(o[2], o[3]);
                g2 = g1; g1 = Gc; v2 = v1; v1 = Vc; } }
        bf16_t* ap = act + (size_t)(u.pm * BM + t0) * DFF_ + u.pn * HALF + colb;
#pragma unroll
        for (int j = 0; j < 8; ++j) if (!(defer01 && j < 2)) *(u32x4*)(ap + (size_t)j * DFF_) = (u32x4){pk[0][j].x, pk[0][j].y, pk[1][j].x, pk[1][j].y};
    }
};

template <class Epi, class Sched, bool ALIGN_EPI = false, bool SP2 = false>
__device__ __forceinline__ void gemm_phase(PG8_LAS unsigned char* lds, const Gemm g, const Sched& S, const Epi& E, int wave_s) {
    const int tid_ = tid_now(wave_s);
    const int tid = tid_, wid = __builtin_amdgcn_readfirstlane(tid >> 6), lane = tid & 63, wr = wid >> 2, wc = wid & 3, fr = lane & 15, fq = lane >> 4;
    const int K = g.K, nt = K / BK;
    unsigned voffA[2], voffB[2];
#pragma unroll
    for (int i = 0; i < 2; ++i) { int R, C; stage_rc(tid * 16 + i * 8192, R, C); const int Rb = Epi::PERM ? ((R & ~31) + perm32(R & 31)) : R;
        const int Ra = Epi::AROW8 ? (((R >> 6) * 16 + (R & 15)) * 8 + ((R >> 4) & 3)) : R;
        voffA[i] = (unsigned)(Ra * g.lda + C) * 2u; voffB[i] = (unsigned)(Rb * g.ldb + C) * 2u; }
    const size_t kstep = (size_t)(BK * 2);
    const size_t hstepA = (size_t)(Epi::AROW8 ? 4 : HALF) * g.lda * 2, hstepB = (size_t)HALF * g.ldb * 2;
    const size_t tstepA = (size_t)BM * g.lda * 2, tstepB = 2 * hstepB;
    const unsigned ldsw = (unsigned)wid * 1024u;
    const int aoff = lds_byte(wr * 64 + fr, fq * 8), boff = lds_byte(wc * 32 + fr, fq * 8);
#define PG8_SA(b, h) (((b) * 2 + (h)) * HTB)
#define PG8_SB(b, h) ((4 + (b) * 2 + (h)) * HTB)
#define PG8_STAGE(bufoff, gbase, voff) do { _Pragma("unroll") for (int _i = 0; _i < 2; ++_i) \
        __builtin_amdgcn_global_load_lds((const unsigned*)((const char*)(gbase) + (voff)[_i]), (PG8_LAS unsigned*)(lds + (bufoff) + ldsw + _i * 8192), 16, 0, 0); } while (0)
#define PG8_LDA(dst, b, h) do { _Pragma("unroll") for (int m = 0; m < 4; ++m) _Pragma("unroll") for (int k = 0; k < 2; ++k) dst[m][k] = *(const PG8_LAS bf16x8*)(lds + PG8_SA(b, h) + aoff + m * 2048 + k * 1024); } while (0)
#define PG8_LDB(dst, b, h) do { _Pragma("unroll") for (int n = 0; n < 2; ++n) _Pragma("unroll") for (int k = 0; k < 2; ++k) dst[n][k] = *(const PG8_LAS bf16x8*)(lds + PG8_SB(b, h) + boff + n * 2048 + k * 1024); } while (0)
#define PG8_MMA(ai, bj, At, Bt) do { __builtin_amdgcn_s_setprio(1); _Pragma("unroll") for (int m = 0; m < 4; ++m) _Pragma("unroll") for (int n = 0; n < 2; ++n) _Pragma("unroll") for (int k = 0; k < 2; ++k) \
        acc[ai][bj][m][n] = __builtin_amdgcn_mfma_f32_16x16x32_bf16(Bt[n][k], At[m][k], acc[ai][bj][m][n], 0, 0, 0); __builtin_amdgcn_s_setprio(0); } while (0)
#define PG8_WAIT_V(n) asm volatile("s_waitcnt vmcnt(" #n ")" ::: "memory")
#define PG8_WAIT_L(n) asm volatile("s_waitcnt lgkmcnt(" #n ")" ::: "memory")
#define PG8_BAR __builtin_amdgcn_s_barrier()
#define PG8_SCHED __builtin_amdgcn_sched_barrier(0)
    Unit cur, nxt; int ui = 0;
    if (!S.next(0, cur)) return;
    E.prep(tid, cur);
    f32x4 acc[2][2][4][2];
#pragma unroll
    for (int a = 0; a < 2; ++a)
#pragma unroll
        for (int b = 0; b < 2; ++b)
#pragma unroll
            for (int m = 0; m < 4; ++m)
#pragma unroll
                for (int n = 0; n < 2; ++n) acc[a][b][m][n] = (f32x4){0.f, 0.f, 0.f, 0.f};
    bf16x8 At[4][2], B0[2][2], B1[2][2];
    const char* cA = (const char*)g.A + (size_t)cur.pm * tstepA + (size_t)(cur.pn / g.npg) * (size_t)(K * 2); const char* cB = (const char*)g.Bt + (size_t)cur.pn * tstepB;
    S.a_ready(cur);
    if constexpr (SP2) {
        PG8_STAGE(PG8_SB(0, 0), cB, voffB); PG8_STAGE(PG8_SB(0, 1), cB + hstepB, voffB); PG8_STAGE(PG8_SA(0, 0), cA, voffA); PG8_STAGE(PG8_SA(0, 1), cA + hstepA, voffA);
        if (wr == 1) PG8_BAR;
        PG8_WAIT_V(2); PG8_BAR;
        PG8_STAGE(PG8_SB(1, 0), cB + kstep, voffB); PG8_STAGE(PG8_SA(1, 0), cA + kstep, voffA); PG8_STAGE(PG8_SB(1, 1), cB + hstepB + kstep, voffB);
        PG8_WAIT_V(6); PG8_BAR;
    } else {
        PG8_STAGE(PG8_SB(0, 0), cB, voffB); PG8_STAGE(PG8_SA(0, 0), cA, voffA); PG8_STAGE(PG8_SB(0, 1), cB + hstepB, voffB); PG8_STAGE(PG8_SA(0, 1), cA + hstepA, voffA);
        if (wr == 1) PG8_BAR;
        PG8_WAIT_V(4); PG8_BAR;
        PG8_STAGE(PG8_SB(1, 0), cB + kstep, voffB); PG8_STAGE(PG8_SA(1, 0), cA + kstep, voffA); PG8_STAGE(PG8_SB(1, 1), cB + hstepB + kstep, voffB);
        PG8_WAIT_V(6); PG8_BAR;
    }
    for (;;) {
        const bool has_next = S.next(ui + 1, nxt);
        const char* nA = has_next ? (const char*)g.A + (size_t)nxt.pm * tstepA + (size_t)(nxt.pn / g.npg) * (size_t)(K * 2) : cA; const char* nB = has_next ? (const char*)g.Bt + (size_t)nxt.pn * tstepB : cB;
        for (int t = 0; t < nt; t += 2) {
            const bool last = (t == nt - 2);
            const char* a1 = cA + (size_t)(t + 1) * kstep;
            const char* a2 = last ? nA : cA + (size_t)(t + 2) * kstep; const char* b2 = last ? nB : cB + (size_t)(t + 2) * kstep;
            const char* a3 = a2 + kstep; const char* b3 = b2 + kstep;
            if (last && has_next) S.a_ready(nxt);
            if constexpr (SP2) {
            PG8_LDB(B0, 0, 0); PG8_LDB(B1, 0, 1); PG8_SCHED; PG8_LDA(At, 0, 0); PG8_STAGE(PG8_SA(1, 1), a1 + hstepA, voffA);
            PG8_WAIT_V(8); PG8_WAIT_L(0); PG8_BAR; PG8_MMA(0, 0, At, B0); PG8_MMA(0, 1, At, B1); PG8_BAR; PG8_SCHED;
            PG8_LDA(At, 0, 1); PG8_STAGE(PG8_SB(0, 0), b2, voffB); PG8_STAGE(PG8_SB(0, 1), b2 + hstepB, voffB); PG8_STAGE(PG8_SA(0, 0), a2, voffA);
            PG8_WAIT_V(8); PG8_WAIT_L(0); PG8_BAR; PG8_MMA(1, 0, At, B0); PG8_MMA(1, 1, At, B1); PG8_BAR; PG8_SCHED;
            PG8_LDB(B0, 1, 0); PG8_LDB(B1, 1, 1); PG8_SCHED; PG8_LDA(At, 1, 0); PG8_STAGE(PG8_SA(0, 1), a2 + hstepA, voffA);
            PG8_WAIT_V(8); PG8_WAIT_L(0); PG8_BAR; PG8_MMA(0, 0, At, B0); PG8_MMA(0, 1, At, B1); PG8_BAR; PG8_SCHED;
            PG8_LDA(At, 1, 1); PG8_STAGE(PG8_SB(1, 0), b3, voffB); PG8_STAGE(PG8_SB(1, 1), b3 + hstepB, voffB); PG8_STAGE(PG8_SA(1, 0), a3, voffA);
            PG8_WAIT_V(8); PG8_WAIT_L(0); PG8_BAR; PG8_MMA(1, 0, At, B0); PG8_MMA(1, 1, At, B1); PG8_BAR; PG8_SCHED;
            } else {
            PG8_LDB(B0, 0, 0); PG8_SCHED; PG8_LDA(At, 0, 0); PG8_STAGE(PG8_SA(1, 1), a1 + hstepA, voffA);
            PG8_WAIT_L(8); PG8_BAR; PG8_WAIT_L(0); PG8_MMA(0, 0, At, B0); PG8_BAR; PG8_SCHED;
            PG8_LDB(B1, 0, 1); PG8_STAGE(PG8_SB(0, 0), b2, voffB);
            PG8_BAR; PG8_WAIT_L(0); PG8_MMA(0, 1, At, B1); PG8_BAR;
            PG8_LDA(At, 0, 1); PG8_STAGE(PG8_SA(0, 0), a2, voffA);
            PG8_BAR; PG8_WAIT_L(0); PG8_MMA(1, 0, At, B0); PG8_BAR; PG8_SCHED;
            PG8_STAGE(PG8_SB(0, 1), b2 + hstepB, voffB);
            PG8_WAIT_V(6); PG8_BAR; PG8_MMA(1, 1, At, B1); PG8_BAR;
            PG8_LDB(B0, 1, 0); PG8_SCHED; PG8_LDA(At, 1, 0); PG8_STAGE(PG8_SA(0, 1), a2 + hstepA, voffA);
            PG8_WAIT_L(8); PG8_BAR; PG8_WAIT_L(0); PG8_MMA(0, 0, At, B0); PG8_BAR; PG8_SCHED;
            PG8_LDB(B1, 1, 1); PG8_STAGE(PG8_SB(1, 0), b3, voffB);
            PG8_BAR; PG8_WAIT_L(0); PG8_MMA(0, 1, At, B1); PG8_BAR;
            PG8_LDA(At, 1, 1); PG8_STAGE(PG8_SA(1, 0), a3, voffA);
            PG8_BAR; PG8_WAIT_L(0); PG8_MMA(1, 0, At, B0); PG8_BAR; PG8_SCHED;
            PG8_STAGE(PG8_SB(1, 1), b3 + hstepB, voffB);
            PG8_WAIT_V(6); PG8_BAR; PG8_MMA(1, 1, At, B1); PG8_BAR;
            }
        }
        if constexpr (ALIGN_EPI) { if (wr == 0) PG8_BAR; }
        if constexpr (!Epi::AFTER_DRAIN) { E(acc, cur, wr, wc, fr, fq); S.done(cur); }
        if (!has_next) break;
#pragma unroll
        for (int a = 0; a < 2; ++a)
#pragma unroll
            for (int b = 0; b < 2; ++b)
#pragma unroll
                for (int m = 0; m < 4; ++m)
#pragma unroll
                    for (int n = 0; n < 2; ++n) acc[a][b][m][n] = (f32x4){0.f, 0.f, 0.f, 0.f};
        cur = nxt; cA = nA; cB = nB; ++ui;
        if constexpr (ALIGN_EPI) { if (wr == 1) PG8_BAR; }
    }
    PG8_WAIT_V(0);
    if constexpr (!ALIGN_EPI) { if (wr == 0) PG8_BAR; }
    PG8_BAR;
    if constexpr (Epi::AFTER_DRAIN) { E.fused(acc, cur, wr, wc, fr, fq, lds, wid, lane); S.done(cur); }
#undef PG8_SA
#undef PG8_SB
#undef PG8_STAGE
#undef PG8_LDA
#undef PG8_LDB
#undef PG8_MMA
#undef PG8_WAIT_V
#undef PG8_WAIT_L
#undef PG8_BAR
#undef PG8_SCHED
}
}

constexpr int NWAVES = 8, NTHR = 512;
constexpr int BATCH = 2, SEQ = 8192, DM = 2048, M = BATCH * SEQ, DEPTH = 4;
constexpr int NH = 32, NKV = 4, HD = 64, NQKV = (NH + 2 * NKV) * HD;
constexpr int DFF = 5632, NUP = 2 * DFF;
constexpr int PG = 512;
constexpr float EPS = 1e-6f, LOG2E = 1.4426950408889634f;

constexpr size_t WS_SS = 0;
constexpr size_t WS_BT = WS_SS + (size_t)9 * M * 32 * 4;
constexpr size_t WS_BAR = WS_BT + 32 * 128 * 4;
constexpr size_t WS_WQKV = (size_t)20 << 20;
constexpr size_t WS_WO = WS_WQKV + (size_t)2 * NQKV * DM * 2;
constexpr size_t WS_WUP = WS_WO + (size_t)2 * DM * DM * 2;
constexpr size_t WS_WDN = WS_WUP + (size_t)4 * NUP * DM * 2;
constexpr size_t WS_WPL = WS_WDN + (size_t)4 * DM * DFF * 2;
constexpr size_t WS_XB = WS_WPL + (size_t)2 * DM * PG * 2;
constexpr size_t WS_QKV = WS_XB + (size_t)M * DM * 2;
constexpr size_t WS_OB = WS_QKV + (size_t)M * NQKV * 2;
constexpr size_t WS_ACT = WS_OB + (size_t)M * DM * 2;
constexpr size_t WS_HB = WS_ACT + (size_t)M * DFF * 2;
constexpr size_t WS_END = WS_HB + (size_t)64 * 4 * NUP * 4;

constexpr int LDS_BYTES = 147456;

#define LAS __attribute__((address_space(3)))
typedef unsigned short bf16;
typedef unsigned v4u __attribute__((ext_vector_type(4)));
typedef unsigned v2u __attribute__((ext_vector_type(2)));
typedef float f32x4 __attribute__((ext_vector_type(4)));
typedef float f32x16 __attribute__((ext_vector_type(16)));
typedef short bf16x8 __attribute__((ext_vector_type(8)));
#define LDS_WAIT() asm volatile("s_waitcnt lgkmcnt(0)" ::: "memory")
__device__ __forceinline__ unsigned f2bf(float f) { unsigned u = __builtin_bit_cast(unsigned, f); return (u + 0x7fffu + ((u >> 16) & 1u)) >> 16; }
typedef float f32x2_t __attribute__((ext_vector_type(2))); typedef __bf16 bf16x2_t __attribute__((ext_vector_type(2)));
__device__ __forceinline__ unsigned pk2(float lo, float hi) { f32x2_t v = {lo, hi}; bf16x2_t b = __builtin_convertvector(v, bf16x2_t); return __builtin_bit_cast(unsigned, b); }
__device__ __forceinline__ float bflo(unsigned w) { return __builtin_bit_cast(float, w << 16); }
__device__ __forceinline__ float bfhi(unsigned w) { return __builtin_bit_cast(float, w & 0xffff0000u); }
__device__ __forceinline__ float wave_sum(float v) {
#pragma unroll
    for (int o = 1; o < 64; o <<= 1) v += __shfl_xor(v, o);
    return v;
}

struct Args { const float* in[15]; float* out; unsigned char* ws; };
enum { I_X = 0, I_NMIX, I_NFFN, I_RELB, I_WQKV, I_QG, I_KG, I_SINK, I_WO, I_PW, I_PS, I_WUP, I_CW, I_CB, I_WDN };

struct TDesc { const float* W; int ldw, col0; bf16* WT; int K, row0; const float* gain; int k0; };
__device__ __forceinline__ void ti_load(const TDesc& d, float (&wv)[32], int lane) {
#pragma unroll
    for (int i = 0; i < 32; ++i) wv[i] = d.W[(size_t)(d.k0 + 2 * i + (lane >> 5)) * d.ldw + d.col0 + (lane & 31)];
}
__device__ __forceinline__ void ti_finish(const TDesc& d, const float (&wv)[32], LAS float* scr, int lane) {
#pragma unroll
    for (int i = 0; i < 32; ++i) { const int kk = 2 * i + (lane >> 5); float v = wv[i]; if (d.gain) v *= d.gain[d.k0 + kk]; scr[kk * 33 + (lane & 31)] = v; }
    LDS_WAIT(); asm volatile("" ::: "memory");
    const int c = lane & 7;
#pragma unroll
    for (int j = 0; j < 4; ++j) { const int n = (lane >> 3) + 8 * j; const LAS float* s = scr + (8 * c) * 33 + n;
        v4u o; o.x = pk2(s[0 * 33], s[1 * 33]); o.y = pk2(s[2 * 33], s[3 * 33]); o.z = pk2(s[4 * 33], s[5 * 33]); o.w = pk2(s[6 * 33], s[7 * 33]);
        *(v4u*)(d.WT + (size_t)(d.row0 + n) * d.K + d.k0 + 8 * c) = o; }
    LDS_WAIT(); asm volatile("" ::: "memory");
}
struct CvtPtrs { const float *wup, *nffn, *wdn, *wqkv, *nmix, *wo, *pw, *x, *relb; unsigned char* ws; };
__device__ __forceinline__ TDesc decode_item(const CvtPtrs& a, int r) {
    unsigned char* ws = a.ws;
    constexpr int I_QKV1 = (DM / 64) * (NQKV / 32), I_O1 = (DM / 64) * (DM / 32), I_UP1 = (DM / 64) * (NUP / 32), I_DN1 = (DFF / 64) * (DM / 32), I_PL1 = (PG / 64) * (PG / 32);
    if (r < 4 * I_UP1) { const int l = r / I_UP1; r -= l * I_UP1; const int nblk = NUP / 32, kb = r / nblk, nb = r % nblk, n0 = nb * 32;
        const int src = ((n0 >> 7) & 1) * DFF + (n0 >> 8) * 128 + (n0 & 127);
        return TDesc{a.wup + (size_t)l * DM * NUP, NUP, src, (bf16*)(ws + WS_WUP) + (size_t)l * NUP * DM, DM, n0, a.nffn + l * DM, kb * 64}; }
    r -= 4 * I_UP1;
    if (r < 4 * I_DN1) { const int l = r / I_DN1; r -= l * I_DN1; const int nblk = DM / 32, kb = r / nblk, nb = r % nblk;
        return TDesc{a.wdn + (size_t)l * DFF * DM, DM, nb * 32, (bf16*)(ws + WS_WDN) + (size_t)l * DM * DFF, DFF, nb * 32, nullptr, kb * 64}; }
    r -= 4 * I_DN1;
    if (r < 2 * I_QKV1) { const int l = r / I_QKV1; r -= l * I_QKV1; const int nblk = NQKV / 32, kb = r / nblk, nb = r % nblk;
        return TDesc{a.wqkv + (size_t)l * DM * NQKV, NQKV, nb * 32, (bf16*)(ws + WS_WQKV) + (size_t)l * NQKV * DM, DM, nb * 32, a.nmix + (2 * l) * DM, kb * 64}; }
    r -= 2 * I_QKV1;
    if (r < 2 * I_O1) { const int l = r / I_O1; r -= l * I_O1; const int nblk = DM / 32, kb = r / nblk, nb = r % nblk;
        return TDesc{a.wo + (size_t)l * DM * DM, DM, nb * 32, (bf16*)(ws + WS_WO) + (size_t)l * DM * DM, DM, nb * 32, nullptr, kb * 64}; }
    r -= 2 * I_O1;
    { const int lg = r / I_PL1; r -= lg * I_PL1; const int l = lg >> 2, g = lg & 3; const int nblk = PG / 32, kb = r / nblk, nb = r % nblk;
      return TDesc{a.pw + (size_t)lg * PG * PG, PG, nb * 32, (bf16*)(ws + WS_WPL) + (size_t)l * DM * PG, PG, g * PG + nb * 32, a.nmix + (2 * l + 1) * DM + g * PG, kb * 64}; }
}
template <bool DUAL = true> __device__ __forceinline__ void prologue_phase(const CvtPtrs& a, LAS unsigned char* lds, int lo, int hi, int gw, int NGW, bool do_rows, int tid_in) {
    int tid_ = tid_in; asm volatile("" : "+v"(tid_));
    const int tid = tid_, lane = tid & 63, wave = __builtin_amdgcn_readfirstlane(tid >> 6);
    LAS float* scrA = (LAS float*)(lds + wave * 17408); LAS float* scrB = scrA + 2176;
    unsigned char* ws = a.ws;
    if constexpr (!DUAL) { for (int it = lo + gw; it < hi; it += NGW) { const TDesc d1 = decode_item(a, it); float w1[32]; ti_load(d1, w1, lane); ti_finish(d1, w1, scrA, lane); } return; }
    for (int it = lo + gw; it < hi; it += 2 * NGW) { const int it2 = it + NGW; const bool two = it2 < hi;
        const TDesc d1 = decode_item(a, it), d2 = decode_item(a, two ? it2 : it);
        float w1[32], w2[32];
        ti_load(d1, w1, lane); if (two) ti_load(d2, w2, lane);
        ti_finish(d1, w1, scrA, lane); if (two) ti_finish(d2, w2, scrB, lane); }
    if (!do_rows) return;
    float* ss = (float*)(ws + WS_SS); bf16* xb = (bf16*)(ws + WS_XB); const float* x = a.x;
    for (int m = gw; m < M; m += NGW) { const f32x4* xr = (const f32x4*)(x + (size_t)m * DM) + lane; unsigned long long* o8 = (unsigned long long*)(xb + (size_t)m * DM) + lane; float s = 0.f;
#pragma unroll
        for (int j = 0; j < 8; ++j) { const f32x4 v = xr[64 * j]; s += (v.x * v.x + v.y * v.y) + (v.z * v.z + v.w * v.w); o8[64 * j] = (unsigned long long)pk2(v.x, v.y) | ((unsigned long long)pk2(v.z, v.w) << 32); }
        s = wave_sum(s); if (lane < 32) ss[(size_t)m * 32 + lane] = (lane == 0) ? s : 0.f; }
    if (blockIdx.x == 0) { float* bt = (float*)(ws + WS_BT);
        for (int e = tid; e < NH * 128; e += NTHR) { const int h = e >> 7, n = e & 127; int bk = n;
            if (n >= 16) { bk = 16 + (int)(logf((float)n / 16.0f) / logf(8.0f) * 16.0f); bk = bk > 31 ? 31 : bk; }
            bt[e] = a.relb[h * 32 + bk] * LOG2E; } }
}

constexpr int KS_STRIDE = 72, VT_STRIDE = 260;
constexpr int ALDS_K = 0, ALDS_V = 256 * KS_STRIDE * 2, ALDS_B = ALDS_V + 64 * VT_STRIDE * 2, ALDS_END = ALDS_B + 8 * 192 * 4;
constexpr int ALDS_OST = 81920;
__device__ __forceinline__ int crow(int r, int hi) { return (r & 3) + 8 * (r >> 2) + 4 * hi; }
__device__ __forceinline__ void attn_phase(int wave_s, LAS unsigned char* lds, const bf16* QKV, bf16* O, const float* qg, const float* kg, const float* sinks, const float* bt) {
    const int tid_ = tid_now(wave_s);
    const int tid = tid_, lane = tid & 63, r32 = lane & 31, hi = lane >> 5, wid = __builtin_amdgcn_readfirstlane(tid >> 6);
    LAS bf16* Ks = (LAS bf16*)(lds + ALDS_K); LAS bf16* Vt = (LAS bf16*)(lds + ALDS_V); LAS float* Bs = (LAS float*)(lds + ALDS_B);
    float gq = 0.f, gk = 0.f;
    for (int d = 0; d < HD; ++d) { gq = fmaxf(gq, fabsf(qg[d])); gk = fmaxf(gk, fabsf(kg[d])); }
    const float shift = 8.0f * gq * gk;
    for (int unit = blockIdx.x; unit < BATCH * 64 * NKV; unit += gridDim.x) {
        const int kvh = unit & 3, nb = (unit >> 2) & 63, b = unit >> 8;
        __syncthreads();
        const long rowbase = (long)b * SEQ + (long)(nb - 1) * 128;
#pragma unroll
        for (int i = 0; i < 4; ++i) { int tq = tid; asm volatile("" : "+v"(tq)); const int p = tq + NTHR * i, jrow = p >> 3, ch = p & 7; const bool ok = (nb > 0) || (jrow >= 128);
            v4u kw = (v4u){0u, 0u, 0u, 0u}, vw = (v4u){0u, 0u, 0u, 0u};
            if (ok) { const bf16* src = QKV + (size_t)(rowbase + jrow) * NQKV + NH * HD + kvh * HD + ch * 8; kw = *(const v4u*)src; vw = *(const v4u*)(src + NKV * HD); }
            float kf[8] = {bflo(kw.x), bfhi(kw.x), bflo(kw.y), bfhi(kw.y), bflo(kw.z), bfhi(kw.z), bflo(kw.w), bfhi(kw.w)};
            float s = 0.f;
#pragma unroll
            for (int e = 0; e < 8; ++e) s += kf[e] * kf[e];
            s = sum8(s);
            const float rs = __builtin_amdgcn_rsqf(s * (1.0f / 64.0f) + EPS);
            const f32x4 g0 = *(const f32x4*)(kg + ch * 8), g1 = *(const f32x4*)(kg + ch * 8 + 4);
            v4u ko; ko.x = pk2(kf[0] * rs * g0.x, kf[1] * rs * g0.y); ko.y = pk2(kf[2] * rs * g0.z, kf[3] * rs * g0.w); ko.z = pk2(kf[4] * rs * g1.x, kf[5] * rs * g1.y); ko.w = pk2(kf[6] * rs * g1.z, kf[7] * rs * g1.w);
            *(LAS v4u*)(Ks + jrow * KS_STRIDE + ch * 8) = ko;
            LAS bf16* vd = Vt + (ch * 8) * VT_STRIDE + jrow;
            vd[0 * VT_STRIDE] = (bf16)(vw.x & 0xffffu); vd[1 * VT_STRIDE] = (bf16)(vw.x >> 16); vd[2 * VT_STRIDE] = (bf16)(vw.y & 0xffffu); vd[3 * VT_STRIDE] = (bf16)(vw.y >> 16);
            vd[4 * VT_STRIDE] = (bf16)(vw.z & 0xffffu); vd[5 * VT_STRIDE] = (bf16)(vw.z >> 16); vd[6 * VT_STRIDE] = (bf16)(vw.w & 0xffffu); vd[7 * VT_STRIDE] = (bf16)(vw.w >> 16); }
        for (int e = tid; e < 8 * 192; e += NTHR) { const int hh = e / 192, dist = e % 192 - 32; Bs[e] = (dist >= 0 && dist < 128) ? bt[(kvh * 8 + hh) * 128 + dist] - shift * LOG2E : -1e30f; }
        __syncthreads();
        const int h = kvh * 8 + wid; const float sink2 = (sinks[h] - shift) * LOG2E;
        const LAS float* Bh = Bs + wid * 192 + (r32 - 4 * hi);
        LAS float* wsf = (LAS float*)(lds + ALDS_END) + wid * 32;
        const bf16* Qb = QKV + ((size_t)b * SEQ + nb * 128 + r32) * NQKV + h * HD + hi * 8;
        v4u qw[4];
#pragma unroll
        for (int d0 = 0; d0 < 4; ++d0) qw[d0] = *(const v4u*)(Qb + d0 * 16);
#pragma unroll 1
        for (int c = 0; c < 4; ++c) {
            bf16x8 qr[4];
            { float s = 0.f;
#pragma unroll
                for (int d0 = 0; d0 < 4; ++d0) {
                    const float f0 = bflo(qw[d0].x), f1 = bfhi(qw[d0].x), f2 = bflo(qw[d0].y), f3 = bfhi(qw[d0].y), f4 = bflo(qw[d0].z), f5 = bfhi(qw[d0].z), f6 = bflo(qw[d0].w), f7 = bfhi(qw[d0].w);
                    s += (f0 * f0 + f1 * f1) + (f2 * f2 + f3 * f3) + (f4 * f4 + f5 * f5) + (f6 * f6 + f7 * f7); }
                s = sum_x32(s);
                const float rs = __builtin_amdgcn_rsqf(s * (1.0f / 64.0f) + EPS) * (0.125f * LOG2E);
#pragma unroll
                for (int d0 = 0; d0 < 4; ++d0) { const f32x4 g0 = *(const f32x4*)(qg + d0 * 16 + hi * 8), g1 = *(const f32x4*)(qg + d0 * 16 + hi * 8 + 4);
                    v4u o; o.x = pk2(bflo(qw[d0].x) * rs * g0.x, bfhi(qw[d0].x) * rs * g0.y); o.y = pk2(bflo(qw[d0].y) * rs * g0.z, bfhi(qw[d0].y) * rs * g0.w);
                    o.z = pk2(bflo(qw[d0].z) * rs * g1.x, bfhi(qw[d0].z) * rs * g1.y); o.w = pk2(bflo(qw[d0].w) * rs * g1.z, bfhi(qw[d0].w) * rs * g1.w);
                    qr[d0] = __builtin_bit_cast(bf16x8, o); } }
            if (c < 3) {
#pragma unroll
                for (int d0 = 0; d0 < 4; ++d0) qw[d0] = *(const v4u*)(Qb + (size_t)(32 * (c + 1)) * NQKV + d0 * 16); }
            f32x16 p[5]; float l = 0.f;
#pragma unroll
            for (int kk = 0; kk < 5; ++kk) { const bool blk_ok = (nb > 0) || (c + kk >= 4);
                if (blk_ok) {
#pragma unroll
                    for (int r = 0; r < 16; ++r) p[kk][r] = Bh[160 - 32 * kk - (r & 3) - 8 * (r >> 2)];
#pragma unroll
                    for (int d0 = 0; d0 < 4; ++d0) { const bf16x8 kf = *(const LAS bf16x8*)(Ks + ((c + kk) * 32 + r32) * KS_STRIDE + d0 * 16 + hi * 8);
                        p[kk] = __builtin_amdgcn_mfma_f32_32x32x16_bf16(kf, qr[d0], p[kk], 0, 0, 0); }
                } else p[kk] = (f32x16){}; }
#pragma unroll
            for (int kk = 0; kk < 5; ++kk) { const bool blk_ok = (nb > 0) || (c + kk >= 4);
                if (blk_ok) {
#pragma unroll
                    for (int r = 0; r < 16; ++r) { const float e = __builtin_amdgcn_exp2f(p[kk][r]); p[kk][r] = e; l += e; } } }
            l = sum_x32(l); l += __builtin_amdgcn_exp2f(sink2);
            if (hi == 0) wsf[r32] = __builtin_amdgcn_rcpf(l);
            f32x16 o[2]; o[0] = (f32x16){}; o[1] = (f32x16){};
#pragma unroll
            for (int kk = 0; kk < 5; ++kk) { const bool blk_ok = (nb > 0) || (c + kk >= 4);
                if (blk_ok) {
#pragma unroll
                    for (int ks = 0; ks < 2; ++ks) { v4u pw; pw.x = pk2(p[kk][8 * ks + 0], p[kk][8 * ks + 1]); pw.y = pk2(p[kk][8 * ks + 2], p[kk][8 * ks + 3]);
                        pw.z = pk2(p[kk][8 * ks + 4], p[kk][8 * ks + 5]); pw.w = pk2(p[kk][8 * ks + 6], p[kk][8 * ks + 7]);
                        const bf16x8 pa = __builtin_bit_cast(bf16x8, pw);
#pragma unroll
                        for (int db = 0; db < 2; ++db) { const LAS bf16* vp = Vt + (db * 32 + r32) * VT_STRIDE + 32 * (c + kk) + 16 * ks + 4 * hi;
                            const v2u lo = *(const LAS v2u*)vp, hh = *(const LAS v2u*)(vp + 8); const v4u vv = (v4u){lo.x, lo.y, hh.x, hh.y};
                            o[db] = __builtin_amdgcn_mfma_f32_32x32x16_bf16(pa, __builtin_bit_cast(bf16x8, vv), o[db], 0, 0, 0); } } } }
            LDS_WAIT();
            LAS bf16* stg = (LAS bf16*)(lds + ALDS_OST) + wid * 2048;
#pragma unroll
            for (int rq = 0; rq < 4; ++rq) { const f32x4 iv = *(const LAS f32x4*)(wsf + 8 * rq + 4 * hi);
#pragma unroll
                for (int e = 0; e < 4; ++e) { const int r = 4 * rq + e, q = 8 * rq + 4 * hi + e; stg[q * 64 + r32] = (bf16)(pk2(o[0][r] * iv[e], 0.f) & 0xffffu); stg[q * 64 + 32 + r32] = (bf16)(pk2(o[1][r] * iv[e], 0.f) & 0xffffu); } }
            LDS_WAIT();
            bf16* Ow = O + ((size_t)b * SEQ + nb * 128 + 32 * c) * DM + h * HD;
#pragma unroll
            for (int i = 0; i < 4; ++i) { const int row = i * 8 + (lane >> 3), ch = lane & 7; const v4u v = *(const LAS v4u*)(stg + row * 64 + ch * 8); *(v4u*)(Ow + (size_t)row * DM + ch * 8) = v; }
        }
    }
}

template <int W> __device__ __forceinline__ void pooldiff_strip(const bf16* __restrict__ xc, bf16* __restrict__ dc, const LAS float* rsl, int pos0) {
    v2u xr[W - 1 + 32];
#pragma unroll
    for (int i = 0; i < W - 1 + 32; ++i) { const int rel = i - (W - 1); xr[i] = (pos0 + rel >= 0) ? *(const v2u*)(xc + (long)rel * DM) : (v2u){0u, 0u}; }
#define UNP(w_, r_) ((f32x4){bflo((w_).x), bfhi((w_).x), bflo((w_).y), bfhi((w_).y)} * (r_))
    f32x4 s = (f32x4){0.f, 0.f, 0.f, 0.f};
#pragma unroll
    for (int i = 0; i < W - 1; ++i) s += UNP(xr[i], rsl[16 - (W - 1) + i]);
#pragma unroll
    for (int tt = 0; tt < 32; ++tt) { const f32x4 v = UNP(xr[W - 1 + tt], rsl[16 + tt]); s += v;
        const int cnt = (pos0 + tt + 1) < W ? (pos0 + tt + 1) : W; const f32x4 dd = s * __builtin_amdgcn_rcpf((float)cnt) - v;
        v2u o; o.x = pk2(dd.x, dd.y); o.y = pk2(dd.z, dd.w); *(v2u*)(dc + (long)tt * DM) = o;
        s -= UNP(xr[tt], rsl[16 + tt - (W - 1)]); }
#undef UNP
}
__device__ __forceinline__ void pooldiff_phase(int wave_s, LAS unsigned char* lds, const bf16* x, const float* ss, bf16* d) {
    const int tid_ = tid_now(wave_s);
    const int tid = tid_; const int g = __builtin_amdgcn_readfirstlane(tid >> 7);
    LAS float* rsl = (LAS float*)lds;
    for (int strip = blockIdx.x; strip < M / 32; strip += gridDim.x) {
        const int t0 = strip * 32, pos0 = t0 & (SEQ - 1);
        __syncthreads();
        if (tid < 48 * 8) { const int rr = tid >> 3, row = t0 - 16 + rr; float s = 0.f;
            if (row >= 0) { const f32x4 v = *(const f32x4*)(ss + (size_t)row * 32 + (tid & 7) * 4); s = (v[0] + v[1]) + (v[2] + v[3]); }
            s = sum8(s);
            if ((tid & 7) == 0) rsl[rr] = __builtin_amdgcn_rsqf(s * (1.0f / 2048.0f) + EPS); }
        __syncthreads();
        const bf16* xc = x + (size_t)t0 * DM + 4 * tid; bf16* dc = d + (size_t)t0 * DM + 4 * tid;
        if (g == 0) pooldiff_strip<2>(xc, dc, rsl, pos0); else if (g == 1) pooldiff_strip<4>(xc, dc, rsl, pos0); else if (g == 2) pooldiff_strip<8>(xc, dc, rsl, pos0); else pooldiff_strip<16>(xc, dc, rsl, pos0);
    }
}

__device__ __forceinline__ void fixup_panel(int wave_s, int pm, const float* hbuf, const float* cw, const float* cb, bf16* act) {
    const int tid_ = tid_now(wave_s);
    const int tid = tid_;
    if ((pm & 31) == 0) return;
    for (int cgi = tid; cgi < DFF / 4; cgi += NTHR) { const int ch = cgi * 4;
        const int colg = 256 * (ch >> 7) + (ch & 127);
        const float* hp = hbuf + ((size_t)(pm - 1) * 4 + 2) * NUP + colg; const float* hc = hbuf + (size_t)pm * 4 * NUP + colg;
        const f32x4 gm2 = *(const f32x4*)hp, gm1 = *(const f32x4*)(hp + NUP), g0 = *(const f32x4*)hc, g1 = *(const f32x4*)(hc + NUP);
        const f32x4 vm2 = *(const f32x4*)(hp + 128), vm1 = *(const f32x4*)(hp + NUP + 128), v0 = *(const f32x4*)(hc + 128), v1 = *(const f32x4*)(hc + NUP + 128);
        const f32x4 wg0 = *(const f32x4*)(cw + ch), wg1 = *(const f32x4*)(cw + NUP + ch), wg2 = *(const f32x4*)(cw + 2 * NUP + ch), bg = *(const f32x4*)(cb + ch);
        const f32x4 wv0 = *(const f32x4*)(cw + DFF + ch), wv1 = *(const f32x4*)(cw + NUP + DFF + ch), wv2 = *(const f32x4*)(cw + 2 * NUP + DFF + ch), bv = *(const f32x4*)(cb + DFF + ch);
        const f32x4 gc0 = wg0 * gm2 + wg1 * gm1 + wg2 * g0 + bg, vc0 = wv0 * vm2 + wv1 * vm1 + wv2 * v0 + bv;
        const f32x4 gc1 = wg0 * gm1 + wg1 * g0 + wg2 * g1 + bg, vc1 = wv0 * vm1 + wv1 * v0 + wv2 * v1 + bv;
        f32x4 o0, o1;
#pragma unroll
        for (int i = 0; i < 4; ++i) { o0[i] = gc0[i] * __builtin_amdgcn_rcpf(1.0f + __builtin_amdgcn_exp2f(-gc0[i] * LOG2E)) * vc0[i]; o1[i] = gc1[i] * __builtin_amdgcn_rcpf(1.0f + __builtin_amdgcn_exp2f(-gc1[i] * LOG2E)) * vc1[i]; }
        v2u w0; w0.x = pk2(o0[0], o0[1]); w0.y = pk2(o0[2], o0[3]); v2u w1; w1.x = pk2(o1[0], o1[1]); w1.y = pk2(o1[2], o1[3]);
        *(v2u*)(act + (size_t)(256 * pm) * DFF + ch) = w0; *(v2u*)(act + (size_t)(256 * pm + 1) * DFF + ch) = w1; }
}

#ifndef REP_PRO
#define REP_PRO 1
#endif
#ifndef REP_ATTN
#define REP_ATTN 1
#endif
#ifndef REP_POOL
#define REP_POOL 1
#endif
#ifndef REP_CONV
#define REP_CONV 1
#endif
typedef const __attribute__((address_space(4))) Args* KArgs;
__device__ __forceinline__ KArgs kargs() { KArgs ap = (KArgs)__builtin_amdgcn_kernarg_segment_ptr(); asm volatile("" : "+s"(ap)); return ap; }
#define WSP(T, off) ((T*)(ap->ws + (off)))
#define XB_TMO      128
#define XB_XCNT(j)  (256  + 64 * (j))
#define XB_XSUB(j)  (1280 + 64 * (j))
#define XB_XGEN(j)  (2304 + 64 * (j))
#define XB_TOP      3328
#define XB_TOPGEN   3392
#define XCD_BAR_WORDS 3456
#define XB_SPIN_CAP (1u << 20)
constexpr int XB_LDS_OFF = 131072 + 8192;
__device__ __forceinline__ unsigned xb_ld(unsigned* p)              { return __hip_atomic_load(p, __ATOMIC_RELAXED, __HIP_MEMORY_SCOPE_AGENT); }
__device__ __forceinline__ unsigned xb_add(unsigned* p, unsigned v) { return __hip_atomic_fetch_add(p, v, __ATOMIC_RELAXED, __HIP_MEMORY_SCOPE_AGENT); }
__device__ __forceinline__ unsigned xb_xcc_id() { return (unsigned)__builtin_amdgcn_s_getreg((3 << 11) | 20) & 0xFu; }
#define XB_SPIN(cond, bar) do { unsigned _sp = 0; while (cond) { __builtin_amdgcn_s_sleep(1); \
    if ((++_sp & 255u) == 0u) { if (xb_ld(&(bar)[XB_TMO])) break; if (_sp > XB_SPIN_CAP) { atomicAdd(&(bar)[XB_TMO], 1u); break; } } } } while (0)
__device__ __forceinline__ void xcd_barrier_complete(unsigned* bar, unsigned x, unsigned& nloc, unsigned& nx) {
    const unsigned G = gridDim.x * gridDim.y * gridDim.z;
    unsigned sum, cnt, mine, sp = 0u;
    for (;;) {
        sum = 0u; cnt = 0u; mine = 0u;
#pragma unroll
        for (unsigned j = 0; j < 16; ++j) { const unsigned c = xb_ld(&bar[XB_XCNT(j)]); sum += c; cnt += (c > 0u) ? 1u : 0u; mine = (j == x) ? c : mine; }
        if (sum == G) break;
        __builtin_amdgcn_s_sleep(1);
        if ((++sp & 255u) == 0u) { if (xb_ld(&bar[XB_TMO])) break; if (sp > XB_SPIN_CAP) { atomicAdd(&bar[XB_TMO], 1u); break; } }
    }
    nloc = mine > 0u ? mine : 1u; nx = cnt > 0u ? cnt : 1u;
}
__device__ __forceinline__ void grid_bar(int wave_s) {
    asm volatile("s_waitcnt vmcnt(0)" ::: "memory");
    __syncthreads();
    if (tid_now(wave_s) == 0) {
        KArgs ap = kargs(); unsigned* bar = WSP(unsigned, WS_BAR);
        extern __shared__ __attribute__((aligned(16))) unsigned char lds_raw_[];
        volatile LAS unsigned* st = (volatile LAS unsigned*)((LAS unsigned char*)lds_raw_ + XB_LDS_OFF);
        const unsigned x = xb_xcc_id();
        __builtin_amdgcn_s_waitcnt(0);
        unsigned nloc = st[0], nx = st[1];
        if (nloc == 0u) { xcd_barrier_complete(bar, x, nloc, nx); st[0] = nloc; st[1] = nx; }
        const unsigned old = xb_add(&bar[XB_XSUB(x)], 1u);
        const unsigned gen = old / nloc;
        if (old + 1u == (gen + 1u) * nloc) {
            __builtin_amdgcn_fence(__ATOMIC_RELEASE, "agent");
            asm volatile("s_waitcnt vmcnt(0)" ::: "memory");
            const unsigned og = xb_add(&bar[XB_TOP], 1u);
            const unsigned tg = og / nx;
            if (og + 1u == (tg + 1u) * nx) xb_add(&bar[XB_TOPGEN], 1u);
            else XB_SPIN(xb_ld(&bar[XB_TOPGEN]) == tg, bar);
            __builtin_amdgcn_fence(__ATOMIC_ACQUIRE, "agent");
            xb_add(&bar[XB_XGEN(x)], 1u);
            asm volatile("s_waitcnt vmcnt(0)" ::: "memory");
        } else {
            XB_SPIN(xb_ld(&bar[XB_XGEN(x)]) == gen, bar);
            __builtin_amdgcn_fence(__ATOMIC_ACQUIRE, "agent");
            asm volatile("s_waitcnt vmcnt(0)" ::: "memory");
        }
    }
    __syncthreads();
}
__global__ void __launch_bounds__(NTHR, 2) fwd_kernel(Args a_in) {
    extern __shared__ __attribute__((aligned(16))) unsigned char lds_raw[];
    LAS unsigned char* lds = (LAS unsigned char*)lds_raw;
    cg::grid_group grid = cg::this_grid();
    if (threadIdx.x == 0) { volatile LAS unsigned* st = (volatile LAS unsigned*)(lds + XB_LDS_OFF); st[0] = 0u; st[1] = 0u; const unsigned x_ = xb_xcc_id(); st[2] = x_; st[3] = xb_add((unsigned*)(a_in.ws + WS_BAR) + XB_XCNT(x_), 1u); }
    constexpr int IU = (DM / 64) * (NUP / 32), ID = (DFF / 64) * (DM / 32), GDN = 4 * IU, GQ = GDN + 4 * ID, ITEND = GQ + 2 * ((DM / 64) * (NQKV / 32)) + 2 * ((DM / 64) * (DM / 32)) + 8 * ((PG / 64) * (PG / 32)), SLOT_UP = 6656;
    { const int gw0 = (int)(blockIdx.x * NWAVES + (threadIdx.x >> 6)), ngw0 = (int)(gridDim.x * NWAVES);
      const CvtPtrs cp0{a_in.in[I_WUP], a_in.in[I_NFFN], a_in.in[I_WDN], a_in.in[I_WQKV], a_in.in[I_NMIX], a_in.in[I_WO], a_in.in[I_PW], a_in.in[I_X], a_in.in[I_RELB], a_in.ws};
      prologue_phase(cp0, lds, 0, IU, gw0, ngw0, false, (int)threadIdx.x); prologue_phase(cp0, lds, IU + SLOT_UP, 3 * IU, gw0, ngw0, false, (int)threadIdx.x); prologue_phase(cp0, lds, 3 * IU + SLOT_UP, 4 * IU, gw0, ngw0, false, (int)threadIdx.x);
      prologue_phase(cp0, lds, GDN, GDN + ID, gw0, ngw0, false, (int)threadIdx.x); prologue_phase(cp0, lds, GDN + 2 * ID, GDN + 3 * ID, gw0, ngw0, false, (int)threadIdx.x);
      prologue_phase(cp0, lds, GQ, ITEND, gw0, ngw0, true, (int)threadIdx.x); }
    const int wave_s = __builtin_amdgcn_readfirstlane(threadIdx.x >> 6);
    if (gridDim.x == 0x7fffffffu) grid.sync();
    grid_bar(wave_s);
    if (threadIdx.x == 0) { volatile LAS unsigned* st = (volatile LAS unsigned*)(lds + XB_LDS_OFF); unsigned* bw = (unsigned*)(a_in.ws + WS_BAR); bool ok = gridDim.x == 256;
        for (int j = 0; j < 16; ++j) { const unsigned c_ = xb_ld(bw + XB_XCNT(j)); ok = ok && (c_ == (j < 8 ? 32u : 0u)); }
        st[4] = ok ? (st[2] + 8u * st[3]) : (unsigned)blockIdx.x; }
    __syncthreads();
    const int cu_idx = __builtin_amdgcn_readfirstlane((int)((volatile LAS unsigned*)(lds + XB_LDS_OFF))[4]);

    for (int layer = 0; layer < DEPTH; ++layer) {
        const int j = layer >> 1;
        if ((layer & 1) == 0) {
            { KArgs ap = kargs(); const int G = gridDim.x, bx = cu_idx;
              pg8::Gemm g{WSP(bf16, WS_XB), WSP(const bf16, WS_WQKV) + (size_t)j * NQKV * DM, DM, DM, DM, 1 << 20}; pg8::StaticOrder S; S.init(M, NQKV, G, bx);
              pg8::EpiScaleBf16 E{WSP(bf16, WS_QKV), NQKV, WSP(float, WS_SS) + (size_t)(2 * layer) * M * 32, lds};
              pg8::gemm_phase<pg8::EpiScaleBf16, pg8::StaticOrder, true, true>(lds, g, S, E, wave_s); }
            if (cu_idx >= 128 && gridDim.x == 256) {
                KArgs ap = kargs(); const CvtPtrs a2{ap->in[I_WUP], ap->in[I_NFFN], ap->in[I_WDN], ap->in[I_WQKV], ap->in[I_NMIX], ap->in[I_WO], ap->in[I_PW], ap->in[I_X], ap->in[I_RELB], ap->ws};
                const int l = layer + 1, gw1 = (cu_idx - 128) * NWAVES + wave_s;
                prologue_phase<false>(a2, lds, l * IU, l * IU + SLOT_UP, gw1, 128 * NWAVES, false, tid_now(wave_s)); prologue_phase<false>(a2, lds, GDN + l * ID, GDN + (l + 1) * ID, gw1, 128 * NWAVES, false, tid_now(wave_s)); }
            grid_bar(wave_s);
            { KArgs ap = kargs();
              for (int rp_ = 0; rp_ < REP_ATTN; ++rp_) attn_phase(wave_s, lds, WSP(bf16, WS_QKV), WSP(bf16, WS_OB), ap->in[I_QG] + j * HD, ap->in[I_KG] + j * HD, ap->in[I_SINK] + j * NH, WSP(const float, WS_BT)); }
            grid_bar(wave_s);
            { KArgs ap = kargs(); const int G = gridDim.x, bx = cu_idx;
              pg8::Gemm g{WSP(bf16, WS_OB), WSP(const bf16, WS_WO) + (size_t)j * DM * DM, DM, DM, DM, 1 << 20}; pg8::StaticOrder S; S.init(M, DM, G, bx);
              pg8::EpiResidual E{WSP(bf16, WS_XB), nullptr, nullptr, WSP(float, WS_SS) + (size_t)(2 * layer + 1) * M * 32};
              pg8::gemm_phase<pg8::EpiResidual, pg8::StaticOrder, true, true>(lds, g, S, E, wave_s); }
            grid_bar(wave_s);
        } else {
            { KArgs ap = kargs();
              for (int rp_ = 0; rp_ < REP_POOL; ++rp_) pooldiff_phase(wave_s, lds, WSP(bf16, WS_XB), WSP(float, WS_SS) + (size_t)(2 * layer) * M * 32, WSP(bf16, WS_QKV)); }
            grid_bar(wave_s);
            { KArgs ap = kargs(); const int G = gridDim.x, bx = cu_idx;
              pg8::Gemm g{WSP(bf16, WS_QKV), WSP(const bf16, WS_WPL) + (size_t)j * DM * PG, DM, PG, PG, 2}; pg8::StaticOrder S; S.init(M, DM, G, bx);
              pg8::EpiResidual E{WSP(bf16, WS_XB), nullptr, ap->in[I_PS] + j * DM, WSP(float, WS_SS) + (size_t)(2 * layer + 1) * M * 32};
              pg8::gemm_phase<pg8::EpiResidual, pg8::StaticOrder, true, true>(lds, g, S, E, wave_s); }
            grid_bar(wave_s);
        }
        { KArgs ap = kargs(); const int G = gridDim.x, bx = cu_idx;
          pg8::Gemm g{WSP(bf16, WS_XB), WSP(const bf16, WS_WUP) + (size_t)layer * NUP * DM, DM, DM, DM, 1 << 20}; pg8::StaticOrder S; S.init(M, NUP, G, bx);
          pg8::EpiConvAct E{WSP(bf16, WS_ACT), WSP(float, WS_SS) + (size_t)(2 * layer + 1) * M * 32, ap->in[I_CW] + (size_t)layer * 3 * NUP, ap->in[I_CB] + (size_t)layer * NUP, WSP(float, WS_HB), lds};
          pg8::gemm_phase<pg8::EpiConvAct, pg8::StaticOrder, true, true>(lds, g, S, E, wave_s); }
        grid_bar(wave_s);
        { KArgs ap = kargs(); const int G = gridDim.x, bx = cu_idx;
          pg8::Gemm g{WSP(bf16, WS_ACT), WSP(const bf16, WS_WDN) + (size_t)layer * DM * DFF, DFF, DFF, DFF, 1 << 20}; pg8::StaticOrder S; S.init(M, DM, G, bx);
          { pg8::Unit u0; if (S.next(0, u0)) fixup_panel(wave_s, u0.pm, WSP(float, WS_HB), ap->in[I_CW] + (size_t)layer * 3 * NUP, ap->in[I_CB] + (size_t)layer * NUP, WSP(bf16, WS_ACT));
            asm volatile("s_waitcnt vmcnt(0)" ::: "memory"); __syncthreads(); }
          pg8::EpiResidual E{WSP(bf16, WS_XB), (layer == DEPTH - 1) ? ap->out : nullptr, nullptr, WSP(float, WS_SS) + (size_t)(2 * layer + 2) * M * 32};
          pg8::gemm_phase<pg8::EpiResidual, pg8::StaticOrder, true, true>(lds, g, S, E, wave_s); }
        if (layer + 1 < DEPTH) grid_bar(wave_s);
    }
}

extern "C" void kernel_launch(void* const* d_in, const int* in_sizes, int n_in, void* d_out, int out_size, void* d_ws, size_t ws_size, hipStream_t stream) {
    static int grid = 0;
    if (grid == 0) {
        if (n_in != 15 || out_size != M * DM || ws_size < WS_END) { fprintf(stderr, "kernel_launch: unexpected shapes (n_in %d out %d ws %zu need %zu)\n", n_in, out_size, ws_size, (size_t)WS_END); grid = -1; return; }
        int dev = 0, cus = 0, per_cu = 0;
        hipGetDevice(&dev); hipDeviceGetAttribute(&cus, hipDeviceAttributeMultiprocessorCount, dev);
        hipFuncSetAttribute((const void*)fwd_kernel, hipFuncAttributeMaxDynamicSharedMemorySize, LDS_BYTES);
        hipOccupancyMaxActiveBlocksPerMultiprocessor(&per_cu, (const void*)fwd_kernel, NTHR, LDS_BYTES);
        if (per_cu < 1) per_cu = 1;
        (void)hipGetLastError();
        grid = cus * per_cu;
        if (grid > 256) grid = 256;
        if (grid != 256) { fprintf(stderr, "kernel_launch: needs 256 co-resident workgroups, device offers %d\n", grid); grid = -1; return; }
    }
    if (grid < 0) return;
    if (hipMemsetAsync((char*)d_ws + WS_BAR, 0, 16384, stream) != hipSuccess) { fprintf(stderr, "kernel_launch: memset failed\n"); return; }
    Args a{};
    for (int i = 0; i < 15; ++i) a.in[i] = (const float*)d_in[i];
    a.out = (float*)d_out; a.ws = (unsigned char*)d_ws;
    void* args[] = {&a};
    hipError_t e = hipLaunchCooperativeKernel((const void*)fwd_kernel, dim3(grid), dim3(NTHR), args, LDS_BYTES, stream);
    if (e != hipSuccess) fprintf(stderr, "cooperative launch failed: %s (grid %d)\n", hipGetErrorString(e), grid);
}
```

```cpp
#include <hip/hip_runtime.h>
#include <hip/hip_cooperative_groups.h>
#include <cstdio>
#include <cstdint>
namespace cg = cooperative_groups;

__device__ __forceinline__ int tid_now(int wave_s) { int l; asm volatile("v_mbcnt_lo_u32_b32 %0, -1, 0\n\tv_mbcnt_hi_u32_b32 %0, -1, %0" : "=v"(l)); return (wave_s << 6) | l; }

__device__ __forceinline__ float dpp_f(float v, int) { return v; }
#define DPP_MOVF(v, ctrl) __builtin_bit_cast(float, __builtin_amdgcn_update_dpp(0, __builtin_bit_cast(int, (float)(v)), (ctrl), 0xf, 0xf, true))
__device__ __forceinline__ float sum_x1(float s) { return s + DPP_MOVF(s, 0xB1); }
__device__ __forceinline__ float sum8(float s) { s += DPP_MOVF(s, 0xB1); s += DPP_MOVF(s, 0x4E); s += DPP_MOVF(s, 0x141); return s; }
__device__ __forceinline__ float sum_x32(float t) { float a = t, b = t; asm volatile("s_nop 1\n\tv_permlane32_swap_b32 %0, %1" : "+v"(a), "+v"(b)); return a + b; }

namespace pg8 {
#define PG8_LAS __attribute__((address_space(3)))
typedef unsigned short bf16_t;
typedef short bf16x8 __attribute__((ext_vector_type(8)));
typedef float f32x4 __attribute__((ext_vector_type(4)));
typedef unsigned u32x4 __attribute__((ext_vector_type(4)));
typedef unsigned u32x2 __attribute__((ext_vector_type(2)));
constexpr int BM = 256, BK = 64, HALF = 128, HTB = HALF * BK * 2  , STAGE_BYTES = 8 * HTB, NXCD = 8, WGM = 8;

__host__ __device__ __forceinline__ int lds_byte(int r, int c) { const int st = (r >> 4) * 2 + (c >> 5), rr = r & 15, cc = c & 31, ob = rr * 64 + cc * 2; return st * 1024 + (ob ^ (((ob >> 9) & 1) << 5)); }
__host__ __device__ __forceinline__ void stage_rc(int b, int& R, int& C) { const int st = b / 1024, sb = b % 1024, swz = sb ^ (((sb >> 9) & 1) << 5); R = (st >> 1) * 16 + swz / 64; C = (st & 1) * 32 + (swz % 64) / 2; }
__host__ __device__ __forceinline__ int perm32(int rho) { const int n = rho >> 4, i = rho & 15; return 8 * (i >> 2) + 4 * n + (i & 3); }

struct Unit { int pm, pn; };
struct Gemm { const bf16_t* A; const bf16_t* Bt; int lda, ldb, K, npg; };

struct StaticOrder {
    int nM, nN, nwg, G, c;
    __host__ __device__ __forceinline__ void init(int M, int N, int G_, int c_) { nM = M / BM; nN = N / BM; nwg = nM * nN; G = G_; c = c_; }
    __host__ __device__ __forceinline__ bool next(int i, Unit& u) const {
        const long L = (long)i * G + c; if (L >= nwg) return false;
        int wgid = (int)L; { const int q = nwg / NXCD, r = nwg % NXCD, xcd = wgid % NXCD, off = wgid / NXCD; wgid = (xcd < r ? xcd * (q + 1) : r * (q + 1) + (xcd - r) * q) + off; }
        const int nig = WGM * nN, gid = wgid / nig, fm = gid * WGM, gsz = (nM - fm) < WGM ? (nM - fm) : WGM;
        u.pm = fm + ((wgid % nig) % gsz); u.pn = (wgid % nig) / gsz; return true;
    }
    __device__ __forceinline__ void a_ready(const Unit&) const {}
    __device__ __forceinline__ void done(const Unit&) const {}
};

typedef float f32x2c __attribute__((ext_vector_type(2))); typedef __bf16 bf16x2c __attribute__((ext_vector_type(2)));
__device__ __forceinline__ unsigned cvt_pk_bf16(float lo, float hi) { f32x2c v = {lo, hi}; bf16x2c b = __builtin_convertvector(v, bf16x2c); return __builtin_bit_cast(unsigned, b); }

constexpr float RMS_EPS = 1e-6f;
__device__ __forceinline__ float sum_fq(float t) {
    float a = t, b = t; asm volatile("s_nop 1\n\tv_permlane16_swap_b32 %0, %1" : "+v"(a), "+v"(b)); t = a + b;
    a = t; b = t; asm volatile("s_nop 1\n\tv_permlane32_swap_b32 %0, %1" : "+v"(a), "+v"(b)); return a + b; }
__device__ __forceinline__ float row_rstd4(const float* ss, int row, int fq) { const f32x4* p = (const f32x4*)(ss + (size_t)row * 32 + 8 * fq); const f32x4 a = p[0] + p[1];
    float t = sum_fq((a[0] + a[1]) + (a[2] + a[3]));
    return __builtin_amdgcn_rsqf(t * (1.0f / 2048.0f) + RMS_EPS); }
__device__ __forceinline__ float bf_lo(unsigned w) { return __builtin_bit_cast(float, w << 16); }
__device__ __forceinline__ float bf_hi(unsigned w) { return __builtin_bit_cast(float, w & 0xffff0000u); }
constexpr int LDS_X_OFF = 131072, LDS_RS_OFF = 131072 + 8192 + 256, LDS_CW_OFF = LDS_RS_OFF + 1024;
__device__ __forceinline__ void prep_rstd(PG8_LAS unsigned char* lds, const float* ss, int tid, int pm) {
    PG8_LAS float* RS = (PG8_LAS float*)(lds + LDS_RS_OFF);
    const int row = tid >> 1, h = tid & 1; const f32x4* p = (const f32x4*)(ss + (size_t)(pm * BM + row) * 32 + 16 * h);
    f32x4 a = p[0] + p[1]; const f32x4 b = p[2] + p[3]; a += b; float t = (a[0] + a[1]) + (a[2] + a[3]);
    t = sum_x1(t);
    if (h == 0) RS[row] = __builtin_amdgcn_rsqf(t * (1.0f / 2048.0f) + RMS_EPS);
    asm volatile("s_waitcnt lgkmcnt(0)" ::: "memory"); __syncthreads();
}
struct EpiScaleBf16 {
    static constexpr bool PERM = true, AFTER_DRAIN = false, AROW8 = false;
    bf16_t* O; int ldc; const float* ss; PG8_LAS unsigned char* lds;
    __device__ __forceinline__ void prep(int tid, const Unit& u) const { prep_rstd(lds, ss, tid, u.pm); }
    __device__ __forceinline__ void operator()(const f32x4 (&acc)[2][2][4][2], const Unit& u, int wr, int wc, int fr_, int fq_) const {
        int fr = fr_, fq = fq_; asm volatile("" : "+v"(fr), "+v"(fq));
        const int row0 = u.pm * BM + wr * 64 + fr, col0 = u.pn * BM + wc * 32 + 8 * fq;
#pragma unroll
        for (int ai = 0; ai < 2; ++ai)
#pragma unroll
            for (int m = 0; m < 4; ++m) { const int row = row0 + ai * HALF + m * 16; const float rs = ((const PG8_LAS float*)(lds + LDS_RS_OFF))[ai * HALF + wr * 64 + m * 16 + fr];
                bf16_t* rowp = O + (size_t)row * ldc + col0;
#pragma unroll
                for (int bj = 0; bj < 2; ++bj) { const f32x4 v0 = acc[ai][bj][m][0] * rs, v1 = acc[ai][bj][m][1] * rs;
                    u32x4 w; w.x = cvt_pk_bf16(v0[0], v0[1]); w.y = cvt_pk_bf16(v0[2], v0[3]); w.z = cvt_pk_bf16(v1[0], v1[1]); w.w = cvt_pk_bf16(v1[2], v1[3]);
                    *(u32x4*)(rowp + bj * HALF) = w; } }
    }
};
struct EpiResidual {
    static constexpr bool PERM = true, AFTER_DRAIN = false, AROW8 = false;
    bf16_t* xb; float* out; const float* cs; float* ssn;
    __device__ __forceinline__ void prep(int, const Unit&) const {}
    __device__ __forceinline__ void operator()(const f32x4 (&acc)[2][2][4][2], const Unit& u, int wr, int wc, int fr_, int fq_) const {
        int fr = fr_, fq = fq_; asm volatile("" : "+v"(fr), "+v"(fq));
        const int col0 = u.pn * BM + wc * 32 + 8 * fq;
        const size_t off0 = (size_t)(u.pm * BM + wr * 64 + fr) * 2048 + col0;
        u32x4 bw[2][4][2];
#pragma unroll
        for (int ai = 0; ai < 2; ++ai)
#pragma unroll
            for (int m = 0; m < 4; ++m)
#pragma unroll
                for (int bj = 0; bj < 2; ++bj) bw[ai][m][bj] = *(const u32x4*)(xb + off0 + (size_t)(ai * HALF + m * 16) * 2048 + bj * HALF);
        f32x4 cv[2][2];
#pragma unroll
        for (int bj = 0; bj < 2; ++bj)
#pragma unroll
            for (int n = 0; n < 2; ++n) cv[bj][n] = cs ? *(const f32x4*)(cs + col0 + bj * HALF + n * 4) : (f32x4){1.f, 1.f, 1.f, 1.f};
#pragma unroll
        for (int ai = 0; ai < 2; ++ai)
#pragma unroll
            for (int m = 0; m < 4; ++m) { const int row = u.pm * BM + ai * HALF + wr * 64 + m * 16 + fr; const size_t off = off0 + (size_t)(ai * HALF + m * 16) * 2048; float s = 0.f;
#pragma unroll
                for (int bj = 0; bj < 2; ++bj) { const u32x4 w0 = bw[ai][m][bj];
                    const f32x4 v0 = (f32x4){bf_lo(w0.x), bf_hi(w0.x), bf_lo(w0.y), bf_hi(w0.y)} + acc[ai][bj][m][0] * cv[bj][0];
                    const f32x4 v1 = (f32x4){bf_lo(w0.z), bf_hi(w0.z), bf_lo(w0.w), bf_hi(w0.w)} + acc[ai][bj][m][1] * cv[bj][1];
                    if (out) { *(f32x4*)(out + off + bj * HALF) = v0; *(f32x4*)(out + off + bj * HALF + 4) = v1; }
                    u32x4 w; w.x = cvt_pk_bf16(v0[0], v0[1]); w.y = cvt_pk_bf16(v0[2], v0[3]); w.z = cvt_pk_bf16(v1[0], v1[1]); w.w = cvt_pk_bf16(v1[2], v1[3]); if (!out) *(u32x4*)(xb + off + bj * HALF) = w;
                    s += ((v0[0] * v0[0] + v0[1] * v0[1]) + (v0[2] * v0[2] + v0[3] * v0[3])) + ((v1[0] * v1[0] + v1[1] * v1[1]) + (v1[2] * v1[2] + v1[3] * v1[3])); }
                if (!out) { s = sum_fq(s); if (fq == 0) ssn[(size_t)row * 32 + u.pn * 4 + wc] = s; } }
    }
};
__device__ __forceinline__ float dpp_shr1(float v, float old) { return __builtin_bit_cast(float, __builtin_amdgcn_update_dpp(__builtin_bit_cast(int, old), __builtin_bit_cast(int, v), 0x111, 0xf, 0xf, false)); }
__device__ __forceinline__ float dpp_shr2(float v, float old) { return __builtin_bit_cast(float, __builtin_amdgcn_update_dpp(__builtin_bit_cast(int, old), __builtin_bit_cast(int, v), 0x112, 0xf, 0xf, false)); }
__device__ __forceinline__ float dpp_ror1(float v) { return __builtin_bit_cast(float, __builtin_amdgcn_update_dpp(0, __builtin_bit_cast(int, v), 0x121, 0xf, 0xf, false)); }
__device__ __forceinline__ float dpp_ror2(float v) { return __builtin_bit_cast(float, __builtin_amdgcn_update_dpp(0, __builtin_bit_cast(int, v), 0x122, 0xf, 0xf, false)); }
constexpr int NUP_ = 11264, DFF_ = 5632;
struct EpiConvAct {
    static constexpr bool PERM = true, AFTER_DRAIN = false, AROW8 = true;
    bf16_t* act; const float* ss; const float* cw; const float* cb; float* hbuf; PG8_LAS unsigned char* lds;
    __device__ __forceinline__ void prep(int tid, const Unit& u) const { prep_rstd(lds, ss, tid, u.pm); }
    __device__ __forceinline__ void operator()(f32x4 (&acc)[2][2][4][2], const Unit& u, int wr, int wc, int fr_, int fq_) const {
        int fr = fr_, fq = fq_; asm volatile("" : "+v"(fr), "+v"(fq));
        PG8_LAS float* X = (PG8_LAS float*)(lds + LDS_X_OFF); const PG8_LAS float* RS = (const PG8_LAS float*)(lds + LDS_RS_OFF); PG8_LAS float* CW = (PG8_LAS float*)(lds + LDS_CW_OFF);
        typedef float f32x2w __attribute__((ext_vector_type(2)));
        const int t2 = (((wr * 4 + wc) * 64) + fq * 16 + fr) * 2, wk = t2 >> 8, wgv = (t2 >> 7) & 1, wch = t2 & 127;
        const f32x2w wld = *(const f32x2w*)((wk < 3 ? cw + wk * NUP_ : cb) + wgv * DFF_ + u.pn * HALF + wch);
        const int t0 = (wr * 16 + fr) * 8;
        { const f32x4 r0 = *(const PG8_LAS f32x4*)(RS + t0), r1 = *(const PG8_LAS f32x4*)(RS + t0 + 4);
#pragma unroll
          for (int m = 0; m < 4; ++m)
#pragma unroll
            for (int bj = 0; bj < 2; ++bj)
#pragma unroll
                for (int n = 0; n < 2; ++n) { acc[0][bj][m][n] *= r0[m]; acc[1][bj][m][n] *= r1[m]; } }
        const int colb = wc * 32 + 8 * fq;
        if (wr == 0 && fr == 15) {
#pragma unroll
            for (int bj = 0; bj < 2; ++bj)
#pragma unroll
                for (int n = 0; n < 2; ++n) { *(PG8_LAS f32x4*)(X + bj * HALF + n * 4 + colb) = acc[1][bj][2][n]; *(PG8_LAS f32x4*)(X + 256 + bj * HALF + n * 4 + colb) = acc[1][bj][3][n]; } }
        { float* hb = hbuf + (size_t)u.pm * 4 * NUP_ + u.pn * BM + colb;
          if (wr == 0 && fr == 0) {
#pragma unroll
              for (int bj = 0; bj < 2; ++bj)
#pragma unroll
                  for (int n = 0; n < 2; ++n) { *(f32x4*)(hb + bj * HALF + n * 4) = acc[0][bj][0][n]; *(f32x4*)(hb + (size_t)NUP_ + bj * HALF + n * 4) = acc[0][bj][1][n]; } }
          if (wr == 1 && fr == 15) {
#pragma unroll
              for (int bj = 0; bj < 2; ++bj)
#pragma unroll
                  for (int n = 0; n < 2; ++n) { *(f32x4*)(hb + (size_t)2 * NUP_ + bj * HALF + n * 4) = acc[1][bj][2][n]; *(f32x4*)(hb + (size_t)3 * NUP_ + bj * HALF + n * 4) = acc[1][bj][3][n]; } } }
        *(PG8_LAS f32x2w*)(CW + t2) = wld;
        asm volatile("s_waitcnt lgkmcnt(0)" ::: "memory"); __builtin_amdgcn_s_barrier(); asm volatile("" ::: "memory");
        u32x2 pk[2][8];
        const bool defer01 = (u.pm & 31) != 0 && wr == 0 && fr == 0;
#pragma unroll
        for (int n = 0; n < 2; ++n) { const int chl = wc * 32 + 8 * fq + 4 * n;
            const f32x4 wg0 = *(const PG8_LAS f32x4*)(CW + chl), wg1 = *(const PG8_LAS f32x4*)(CW + 256 + chl), wg2 = *(const PG8_LAS f32x4*)(CW + 512 + chl), bg = *(const PG8_LAS f32x4*)(CW + 768 + chl);
            const f32x4 wv0 = *(const PG8_LAS f32x4*)(CW + 128 + chl), wv1 = *(const PG8_LAS f32x4*)(CW + 384 + chl), wv2 = *(const PG8_LAS f32x4*)(CW + 640 + chl), bv = *(const PG8_LAS f32x4*)(CW + 896 + chl);
            f32x4 h6g = (f32x4){0.f, 0.f, 0.f, 0.f}, h7g = h6g, h6v = h6g, h7v = h6g;
            if (wr == 1 && fr == 0) { h6g = *(const PG8_LAS f32x4*)(X + n * 4 + colb); h7g = *(const PG8_LAS f32x4*)(X + 256 + n * 4 + colb); h6v = *(const PG8_LAS f32x4*)(X + HALF + n * 4 + colb); h7v = *(const PG8_LAS f32x4*)(X + 256 + HALF + n * 4 + colb); }
#pragma unroll
            for (int i = 0; i < 4; ++i) { h6g[i] = dpp_shr1(acc[1][0][2][n][i], h6g[i]); h7g[i] = dpp_shr1(acc[1][0][3][n][i], h7g[i]); h6v[i] = dpp_shr1(acc[1][1][2][n][i], h6v[i]); h7v[i] = dpp_shr1(acc[1][1][3][n][i], h7v[i]); }
            f32x4 g2 = h6g, g1 = h7g, v2 = h6v, v1 = h7v;
#pragma unroll
            for (int j = 0; j < 8; ++j) { const f32x4 Gc = acc[j >> 2][0][j & 3][n], Vc = acc[j >> 2][1][j & 3][n];
                const f32x4 gc = wg0 * g2 + wg1 * g1 + wg2 * Gc + bg, vc = wv0 * v2 + wv1 * v1 + wv2 * Vc + bv; f32x4 o;
#pragma unroll
                for (int i = 0; i < 4; ++i) o[i] = gc[i] * __builtin_amdgcn_rcpf(1.0f + __builtin_amdgcn_exp2f(gc[i] * -1.4426950408889634f)) * vc[i];
                pk[n][j].x = cvt_pk_bf16(o[0], o[1]); pk[n][j].y = cvt_pk_bf16(o[2], o[3]);
                g2 = g1; g1 = Gc; v2 = v1; v1 = Vc; } }
        bf16_t* ap = act + (size_t)(u.pm * BM + t0) * DFF_ + u.pn * HALF + colb;
#pragma unroll
        for (int j = 0; j < 8; ++j) if (!(defer01 && j < 2)) *(u32x4*)(ap + (size_t)j * DFF_) = (u32x4){pk[0][j].x, pk[0][j].y, pk[1][j].x, pk[1][j].y};
    }
};

template <class Epi, class Sched, bool ALIGN_EPI = false, bool SP2 = false>
__device__ __forceinline__ void gemm_phase(PG8_LAS unsigned char* lds, const Gemm g, const Sched& S, const Epi& E, int wave_s) {
    const int tid_ = tid_now(wave_s);
    const int tid = tid_, wid = __builtin_amdgcn_readfirstlane(tid >> 6), lane = tid & 63, wr = wid >> 2, wc = wid & 3, fr = lane & 15, fq = lane >> 4;
    const int K = g.K, nt = K / BK;
    unsigned voffA[2], voffB[2];
#pragma unroll
    for (int i = 0; i < 2; ++i) { int R, C; stage_rc(tid * 16 + i * 8192, R, C); const int Rb = Epi::PERM ? ((R & ~31) + perm32(R & 31)) : R;
        const int Ra = Epi::AROW8 ? (((R >> 6) * 16 + (R & 15)) * 8 + ((R >> 4) & 3)) : R;
        voffA[i] = (unsigned)(Ra * g.lda + C) * 2u; voffB[i] = (unsigned)(Rb * g.ldb + C) * 2u; }
    const size_t kstep = (size_t)(BK * 2);
    const size_t hstepA = (size_t)(Epi::AROW8 ? 4 : HALF) * g.lda * 2, hstepB = (size_t)HALF * g.ldb * 2;
    const size_t tstepA = (size_t)BM * g.lda * 2, tstepB = 2 * hstepB;
    const unsigned ldsw = (unsigned)wid * 1024u;
    const int aoff = lds_byte(wr * 64 + fr, fq * 8), boff = lds_byte(wc * 32 + fr, fq * 8);
#define PG8_SA(b, h) (((b) * 2 + (h)) * HTB)
#define PG8_SB(b, h) ((4 + (b) * 2 + (h)) * HTB)
#define PG8_STAGE(bufoff, gbase, voff) do { _Pragma("unroll") for (int _i = 0; _i < 2; ++_i) \
        __builtin_amdgcn_global_load_lds((const unsigned*)((const char*)(gbase) + (voff)[_i]), (PG8_LAS unsigned*)(lds + (bufoff) + ldsw + _i * 8192), 16, 0, 0); } while (0)
#define PG8_LDA(dst, b, h) do { _Pragma("unroll") for (int m = 0; m < 4; ++m) _Pragma("unroll") for (int k = 0; k < 2; ++k) dst[m][k] = *(const PG8_LAS bf16x8*)(lds + PG8_SA(b, h) + aoff + m * 2048 + k * 1024); } while (0)
#define PG8_LDB(dst, b, h) do { _Pragma("unroll") for (int n = 0; n < 2; ++n) _Pragma("unroll") for (int k = 0; k < 2; ++k) dst[n][k] = *(const PG8_LAS bf16x8*)(lds + PG8_SB(b, h) + boff + n * 2048 + k * 1024); } while (0)
#define PG8_MMA(ai, bj, At, Bt) do { __builtin_amdgcn_s_setprio(1); _Pragma("unroll") for (int m = 0; m < 4; ++m) _Pragma("unroll") for (int n = 0; n < 2; ++n) _Pragma("unroll") for (int k = 0; k < 2; ++k) \
        acc[ai][bj][m][n] = __builtin_amdgcn_mfma_f32_16x16x32_bf16(Bt[n][k], At[m][k], acc[ai][bj][m][n], 0, 0, 0); __builtin_amdgcn_s_setprio(0); } while (0)
#define PG8_WAIT_V(n) asm volatile("s_waitcnt vmcnt(" #n ")" ::: "memory")
#define PG8_WAIT_L(n) asm volatile("s_waitcnt lgkmcnt(" #n ")" ::: "memory")
#define PG8_BAR __builtin_amdgcn_s_barrier()
#define PG8_SCHED __builtin_amdgcn_sched_barrier(0)
    Unit cur, nxt; int ui = 0;
    if (!S.next(0, cur)) return;
    E.prep(tid, cur);
    f32x4 acc[2][2][4][2];
#pragma unroll
    for (int a = 0; a < 2; ++a)
#pragma unroll
        for (int b = 0; b < 2; ++b)
#pragma unroll
            for (int m = 0; m < 4; ++m)
#pragma unroll
                for (int n = 0; n < 2; ++n) acc[a][b][m][n] = (f32x4){0.f, 0.f, 0.f, 0.f};
    bf16x8 At[4][2], B0[2][2], B1[2][2];
    const char* cA = (const char*)g.A + (size_t)cur.pm * tstepA + (size_t)(cur.pn / g.npg) * (size_t)(K * 2); const char* cB = (const char*)g.Bt + (size_t)cur.pn * tstepB;
    S.a_ready(cur);
    if constexpr (SP2) {
        PG8_STAGE(PG8_SB(0, 0), cB, voffB); PG8_STAGE(PG8_SB(0, 1), cB + hstepB, voffB); PG8_STAGE(PG8_SA(0, 0), cA, voffA); PG8_STAGE(PG8_SA(0, 1), cA + hstepA, voffA);
        if (wr == 1) PG8_BAR;
        PG8_WAIT_V(2); PG8_BAR;
        PG8_STAGE(PG8_SB(1, 0), cB + kstep, voffB); PG8_STAGE(PG8_SA(1, 0), cA + kstep, voffA); PG8_STAGE(PG8_SB(1, 1), cB + hstepB + kstep, voffB);
        PG8_WAIT_V(6); PG8_BAR;
    } else {
        PG8_STAGE(PG8_SB(0, 0), cB, voffB); PG8_STAGE(PG8_SA(0, 0), cA, voffA); PG8_STAGE(PG8_SB(0, 1), cB + hstepB, voffB); PG8_STAGE(PG8_SA(0, 1), cA + hstepA, voffA);
        if (wr == 1) PG8_BAR;
        PG8_WAIT_V(4); PG8_BAR;
        PG8_STAGE(PG8_SB(1, 0), cB + kstep, voffB); PG8_STAGE(PG8_SA(1, 0), cA + kstep, voffA); PG8_STAGE(PG8_SB(1, 1), cB + hstepB + kstep, voffB);
        PG8_WAIT_V(6); PG8_BAR;
    }
    for (;;) {
        const bool has_next = S.next(ui + 1, nxt);
        const char* nA = has_next ? (const char*)g.A + (size_t)nxt.pm * tstepA + (size_t)(nxt.pn / g.npg) * (size_t)(K * 2) : cA; const char* nB = has_next ? (const char*)g.Bt + (size_t)nxt.pn * tstepB : cB;
        for (int t = 0; t < nt; t += 2) {
            const bool last = (t == nt - 2);
            const char* a1 = cA + (size_t)(t + 1) * kstep;
            const char* a2 = last ? nA : cA + (size_t)(t + 2) * kstep; const char* b2 = last ? nB : cB + (size_t)(t + 2) * kstep;
            const char* a3 = a2 + kstep; const char* b3 = b2 + kstep;
            if (last && has_next) S.a_ready(nxt);
            if constexpr (SP2) {
            PG8_LDB(B0, 0, 0); PG8_LDB(B1, 0, 1); PG8_SCHED; PG8_LDA(At, 0, 0); PG8_STAGE(PG8_SA(1, 1), a1 + hstepA, voffA);
            PG8_WAIT_V(8); PG8_WAIT_L(0); PG8_BAR; PG8_MMA(0, 0, At, B0); PG8_MMA(0, 1, At, B1); PG8_BAR; PG8_SCHED;
            PG8_LDA(At, 0, 1); PG8_STAGE(PG8_SB(0, 0), b2, voffB); PG8_STAGE(PG8_SB(0, 1), b2 + hstepB, voffB); PG8_STAGE(PG8_SA(0, 0), a2, voffA);
            PG8_WAIT_V(8); PG8_WAIT_L(0); PG8_BAR; PG8_MMA(1, 0, At, B0); PG8_MMA(1, 1, At, B1); PG8_BAR; PG8_SCHED;
            PG8_LDB(B0, 1, 0); PG8_LDB(B1, 1, 1); PG8_SCHED; PG8_LDA(At, 1, 0); PG8_STAGE(PG8_SA(0, 1), a2 + hstepA, voffA);
            PG8_WAIT_V(8); PG8_WAIT_L(0); PG8_BAR; PG8_MMA(0, 0, At, B0); PG8_MMA(0, 1, At, B1); PG8_BAR; PG8_SCHED;
            PG8_LDA(At, 1, 1); PG8_STAGE(PG8_SB(1, 0), b3, voffB); PG8_STAGE(PG8_SB(1, 1), b3 + hstepB, voffB); PG8_STAGE(PG8_SA(1, 0), a3, voffA);
            PG8_WAIT_V(8); PG8_WAIT_L(0); PG8_BAR; PG8_MMA(1, 0, At, B0); PG8_MMA(1, 1, At, B1); PG8_BAR; PG8_SCHED;
            } else {
            PG8_LDB(B0, 0, 0); PG8_SCHED; PG8_LDA(At, 0, 0); PG8_STAGE(PG8_SA(1, 1), a1 + hstepA, voffA);
            PG8_WAIT_L(8); PG8_BAR; PG8_WAIT_L(0); PG8_MMA(0, 0, At, B0); PG8_BAR; PG8_SCHED;
            PG8_LDB(B1, 0, 1); PG8_STAGE(PG8_SB(0, 0), b2, voffB);
            PG8_BAR; PG8_WAIT_L(0); PG8_MMA(0, 1, At, B1); PG8_BAR;
            PG8_LDA(At, 0, 1); PG8_STAGE(PG8_SA(0, 0), a2, voffA);
            PG8_BAR; PG8_WAIT_L(0); PG8_MMA(1, 0, At, B0); PG8_BAR; PG8_SCHED;
            PG8_STAGE(PG8_SB(0, 1), b2 + hstepB, voffB);
            PG8_WAIT_V(6); PG8_BAR; PG8_MMA(1, 1, At, B1); PG8_BAR;
            PG8_LDB(B0, 1, 0); PG8_SCHED; PG8_LDA(At, 1, 0); PG8_STAGE(PG8_SA(0, 1), a2 + hstepA, voffA);
            PG8_WAIT_L(8); PG8_BAR; PG8_WAIT_L(0); PG8_MMA(0, 0, At, B0); PG8_BAR; PG8_SCHED;
            PG8_LDB(B1, 1, 1); PG8_STAGE(PG8_SB(1, 0), b3, voffB);
            PG8_BAR; PG8_WAIT_L(0); PG8_MMA(0, 1, At, B1); PG8_BAR;
            PG8_LDA(At, 1, 1); PG8_STAGE(PG8_SA(1, 0), a3, voffA);
            PG8_BAR; PG8_WAIT_L(0); PG8_MMA(1, 0, At, B0); PG8_BAR; PG8_SCHED;
            PG8_STAGE(PG8_SB(1, 1), b3 + hstepB, voffB);
            PG8_WAIT_V(6); PG8_BAR; PG8_MMA(1, 1, At, B1); PG8_BAR;
            }
        }
        if constexpr (ALIGN_EPI) { if (wr == 0) PG8_BAR; }
        if constexpr (!Epi::AFTER_DRAIN) { E(acc, cur, wr, wc, fr, fq); S.done(cur); }
        if (!has_next) break;
#pragma unroll
        for (int a = 0; a < 2; ++a)
#pragma unroll
            for (int b = 0; b < 2; ++b)
#pragma unroll
                for (int m = 0; m < 4; ++m)
#pragma unroll
                    for (int n = 0; n < 2; ++n) acc[a][b][m][n] = (f32x4){0.f, 0.f, 0.f, 0.f};
        cur = nxt; cA = nA; cB = nB; ++ui;
        if constexpr (ALIGN_EPI) { if (wr == 1) PG8_BAR; }
    }
    PG8_WAIT_V(0);
    if constexpr (!ALIGN_EPI) { if (wr == 0) PG8_BAR; }
    PG8_BAR;
    if constexpr (Epi::AFTER_DRAIN) { E.fused(acc, cur, wr, wc, fr, fq, lds, wid, lane); S.done(cur); }
#undef PG8_SA
#undef PG8_SB
#undef PG8_STAGE
#undef PG8_LDA
#undef PG8_LDB
#undef PG8_MMA
#undef PG8_WAIT_V
#undef PG8_WAIT_L
#undef PG8_BAR
#undef PG8_SCHED
}
}

constexpr int NWAVES = 8, NTHR = 512;
constexpr int BATCH = 2, SEQ = 8192, DM = 2048, M = BATCH * SEQ, DEPTH = 4;
constexpr int NH = 32, NKV = 4, HD = 64, NQKV = (NH + 2 * NKV) * HD;
constexpr int DFF = 5632, NUP = 2 * DFF;
constexpr int PG = 512;
constexpr float EPS = 1e-6f, LOG2E = 1.4426950408889634f;

constexpr size_t WS_SS = 0;
constexpr size_t WS_BT = WS_SS + (size_t)9 * M * 32 * 4;
constexpr size_t WS_BAR = WS_BT + 32 * 128 * 4;
constexpr size_t WS_WQKV = (size_t)20 << 20;
constexpr size_t WS_WO = WS_WQKV + (size_t)2 * NQKV * DM * 2;
constexpr size_t WS_WUP = WS_WO + (size_t)2 * DM * DM * 2;
constexpr size_t WS_WDN = WS_WUP + (size_t)4 * NUP * DM * 2;
constexpr size_t WS_WPL = WS_WDN + (size_t)4 * DM * DFF * 2;
constexpr size_t WS_XB = WS_WPL + (size_t)2 * DM * PG * 2;
constexpr size_t WS_QKV = WS_XB + (size_t)M * DM * 2;
constexpr size_t WS_OB = WS_QKV + (size_t)M * NQKV * 2;
constexpr size_t WS_ACT = WS_OB + (size_t)M * DM * 2;
constexpr size_t WS_HB = WS_ACT + (size_t)M * DFF * 2;
constexpr size_t WS_END = WS_HB + (size_t)64 * 4 * NUP * 4;

constexpr int LDS_BYTES = 147456;

#define LAS __attribute__((address_space(3)))
typedef unsigned short bf16;
typedef unsigned v4u __attribute__((ext_vector_type(4)));
typedef unsigned v2u __attribute__((ext_vector_type(2)));
typedef float f32x4 __attribute__((ext_vector_type(4)));
typedef float f32x16 __attribute__((ext_vector_type(16)));
typedef short bf16x8 __attribute__((ext_vector_type(8)));
#define LDS_WAIT() asm volatile("s_waitcnt lgkmcnt(0)" ::: "memory")
__device__ __forceinline__ unsigned f2bf(float f) { unsigned u = __builtin_bit_cast(unsigned, f); return (u + 0x7fffu + ((u >> 16) & 1u)) >> 16; }
typedef float f32x2_t __attribute__((ext_vector_type(2))); typedef __bf16 bf16x2_t __attribute__((ext_vector_type(2)));
__device__ __forceinline__ unsigned pk2(float lo, float hi) { f32x2_t v = {lo, hi}; bf16x2_t b = __builtin_convertvector(v, bf16x2_t); return __builtin_bit_cast(unsigned, b); }
__device__ __forceinline__ float bflo(unsigned w) { return __builtin_bit_cast(float, w << 16); }
__device__ __forceinline__ float bfhi(unsigned w) { return __builtin_bit_cast(float, w & 0xffff0000u); }
__device__ __forceinline__ float wave_sum(float v) {
#pragma unroll
    for (int o = 1; o < 64; o <<= 1) v += __shfl_xor(v, o);
    return v;
}

struct Args { const float* in[15]; float* out; unsigned char* ws; };
enum { I_X = 0, I_NMIX, I_NFFN, I_RELB, I_WQKV, I_QG, I_KG, I_SINK, I_WO, I_PW, I_PS, I_WUP, I_CW, I_CB, I_WDN };

__device__ __forceinline__ void transpose_item(const float* W, int ldw, int col0_src, bf16* WT, int K, int row0_dst, const float* gain, LAS float* scr, int k0, int lane) {
    float wv[32];
#pragma unroll
    for (int i = 0; i < 32; ++i) wv[i] = W[(size_t)(k0 + 2 * i + (lane >> 5)) * ldw + col0_src + (lane & 31)];
#pragma unroll
    for (int i = 0; i < 32; ++i) { const int kk = 2 * i + (lane >> 5); float v = wv[i]; if (gain) v *= gain[k0 + kk]; scr[kk * 33 + (lane & 31)] = v; }
    LDS_WAIT(); asm volatile("" ::: "memory");
    const int c = lane & 7;
#pragma unroll
    for (int j = 0; j < 4; ++j) { const int n = (lane >> 3) + 8 * j; const LAS float* s = scr + (8 * c) * 33 + n;
        v4u o; o.x = pk2(s[0 * 33], s[1 * 33]); o.y = pk2(s[2 * 33], s[3 * 33]); o.z = pk2(s[4 * 33], s[5 * 33]); o.w = pk2(s[6 * 33], s[7 * 33]);
        *(v4u*)(WT + (size_t)(row0_dst + n) * K + k0 + 8 * c) = o; }
    LDS_WAIT(); asm volatile("" ::: "memory");
}
__device__ __forceinline__ void prologue_phase(const Args& a, LAS unsigned char* lds) {
    int tid_ = threadIdx.x; asm volatile("" : "+v"(tid_));
    const int tid = tid_, lane = tid & 63, wave = __builtin_amdgcn_readfirstlane(tid >> 6);
    LAS float* scr = (LAS float*)(lds + wave * 16384);
    const int gw = blockIdx.x * NWAVES + wave, NGW = gridDim.x * NWAVES;
    unsigned char* ws = a.ws;
    constexpr int I_QKV1 = (DM / 64) * (NQKV / 32), I_O1 = (DM / 64) * (DM / 32), I_UP1 = (DM / 64) * (NUP / 32), I_DN1 = (DFF / 64) * (DM / 32), I_PL1 = (PG / 64) * (PG / 32);
    constexpr int NITEMS = 2 * I_QKV1 + 2 * I_O1 + 4 * I_UP1 + 4 * I_DN1 + 8 * I_PL1;
    for (int it = gw; it < NITEMS; it += NGW) {
        int r = it;
        if (r < 4 * I_UP1) { const int l = r / I_UP1; r -= l * I_UP1; const int nblk = NUP / 32, kb = r / nblk, nb = r % nblk, n0 = nb * 32;
            const int src = ((n0 >> 7) & 1) * DFF + (n0 >> 8) * 128 + (n0 & 127);
            transpose_item(a.in[I_WUP] + (size_t)l * DM * NUP, NUP, src, (bf16*)(ws + WS_WUP) + (size_t)l * NUP * DM, DM, n0, a.in[I_NFFN] + l * DM, scr, kb * 64, lane); continue; }
        r -= 4 * I_UP1;
        if (r < 4 * I_DN1) { const int l = r / I_DN1; r -= l * I_DN1; const int nblk = DM / 32, kb = r / nblk, nb = r % nblk;
            transpose_item(a.in[I_WDN] + (size_t)l * DFF * DM, DM, nb * 32, (bf16*)(ws + WS_WDN) + (size_t)l * DM * DFF, DFF, nb * 32, nullptr, scr, kb * 64, lane); continue; }
        r -= 4 * I_DN1;
        if (r < 2 * I_QKV1) { const int l = r / I_QKV1; r -= l * I_QKV1; const int nblk = NQKV / 32, kb = r / nblk, nb = r % nblk;
            transpose_item(a.in[I_WQKV] + (size_t)l * DM * NQKV, NQKV, nb * 32, (bf16*)(ws + WS_WQKV) + (size_t)l * NQKV * DM, DM, nb * 32, a.in[I_NMIX] + (2 * l) * DM, scr, kb * 64, lane); continue; }
        r -= 2 * I_QKV1;
        if (r < 2 * I_O1) { const int l = r / I_O1; r -= l * I_O1; const int nblk = DM / 32, kb = r / nblk, nb = r % nblk;
            transpose_item(a.in[I_WO] + (size_t)l * DM * DM, DM, nb * 32, (bf16*)(ws + WS_WO) + (size_t)l * DM * DM, DM, nb * 32, nullptr, scr, kb * 64, lane); continue; }
        r -= 2 * I_O1;
        { const int lg = r / I_PL1; r -= lg * I_PL1; const int l = lg >> 2, g = lg & 3; const int nblk = PG / 32, kb = r / nblk, nb = r % nblk;
            transpose_item(a.in[I_PW] + (size_t)lg * PG * PG, PG, nb * 32, (bf16*)(ws + WS_WPL) + (size_t)l * DM * PG, PG, g * PG + nb * 32, a.in[I_NMIX] + (2 * l + 1) * DM + g * PG, scr, kb * 64, lane); }
    }
    float* ss = (float*)(ws + WS_SS); bf16* xb = (bf16*)(ws + WS_XB); const float* x = a.in[I_X];
    for (int m = gw; m < M; m += NGW) { const f32x4* xr = (const f32x4*)(x + (size_t)m * DM) + lane; unsigned long long* o8 = (unsigned long long*)(xb + (size_t)m * DM) + lane; float s = 0.f;
#pragma unroll
        for (int j = 0; j < 8; ++j) { const f32x4 v = xr[64 * j]; s += (v.x * v.x + v.y * v.y) + (v.z * v.z + v.w * v.w); o8[64 * j] = (unsigned long long)pk2(v.x, v.y) | ((unsigned long long)pk2(v.z, v.w) << 32); }
        s = wave_sum(s); if (lane < 32) ss[(size_t)m * 32 + lane] = (lane == 0) ? s : 0.f; }
    if (blockIdx.x == 0) { float* bt = (float*)(ws + WS_BT);
        for (int e = tid; e < NH * 128; e += NTHR) { const int h = e >> 7, n = e & 127; int bk = n;
            if (n >= 16) { bk = 16 + (int)(logf((float)n / 16.0f) / logf(8.0f) * 16.0f); bk = bk > 31 ? 31 : bk; }
            bt[e] = a.in[I_RELB][h * 32 + bk] * LOG2E; } }
}

constexpr int KS_STRIDE = 72, VT_STRIDE = 260;
constexpr int ALDS_K = 0, ALDS_V = 256 * KS_STRIDE * 2, ALDS_B = ALDS_V + 64 * VT_STRIDE * 2, ALDS_END = ALDS_B + 8 * 192 * 4;
constexpr int ALDS_OST = 81920;
__device__ __forceinline__ int crow(int r, int hi) { return (r & 3) + 8 * (r >> 2) + 4 * hi; }
__device__ __forceinline__ void attn_phase(int wave_s, LAS unsigned char* lds, const bf16* QKV, bf16* O, const float* qg, const float* kg, const float* sinks, const float* bt) {
    const int tid_ = tid_now(wave_s);
    const int tid = tid_, lane = tid & 63, r32 = lane & 31, hi = lane >> 5, wid = __builtin_amdgcn_readfirstlane(tid >> 6);
    LAS bf16* Ks = (LAS bf16*)(lds + ALDS_K); LAS bf16* Vt = (LAS bf16*)(lds + ALDS_V); LAS float* Bs = (LAS float*)(lds + ALDS_B);
    float gq = 0.f, gk = 0.f;
    for (int d = 0; d < HD; ++d) { gq = fmaxf(gq, fabsf(qg[d])); gk = fmaxf(gk, fabsf(kg[d])); }
    const float shift = 8.0f * gq * gk;
    for (int unit = blockIdx.x; unit < BATCH * 64 * NKV; unit += gridDim.x) {
        const int kvh = unit & 3, nb = (unit >> 2) & 63, b = unit >> 8;
        __syncthreads();
        const long rowbase = (long)b * SEQ + (long)(nb - 1) * 128;
#pragma unroll
        for (int i = 0; i < 4; ++i) { int tq = tid; asm volatile("" : "+v"(tq)); const int p = tq + NTHR * i, jrow = p >> 3, ch = p & 7; const bool ok = (nb > 0) || (jrow >= 128);
            v4u kw = (v4u){0u, 0u, 0u, 0u}, vw = (v4u){0u, 0u, 0u, 0u};
            if (ok) { const bf16* src = QKV + (size_t)(rowbase + jrow) * NQKV + NH * HD + kvh * HD + ch * 8; kw = *(const v4u*)src; vw = *(const v4u*)(src + NKV * HD); }
            float kf[8] = {bflo(kw.x), bfhi(kw.x), bflo(kw.y), bfhi(kw.y), bflo(kw.z), bfhi(kw.z), bflo(kw.w), bfhi(kw.w)};
            float s = 0.f;
#pragma unroll
            for (int e = 0; e < 8; ++e) s += kf[e] * kf[e];
            s = sum8(s);
            const float rs = __builtin_amdgcn_rsqf(s * (1.0f / 64.0f) + EPS);
            const f32x4 g0 = *(const f32x4*)(kg + ch * 8), g1 = *(const f32x4*)(kg + ch * 8 + 4);
            v4u ko; ko.x = pk2(kf[0] * rs * g0.x, kf[1] * rs * g0.y); ko.y = pk2(kf[2] * rs * g0.z, kf[3] * rs * g0.w); ko.z = pk2(kf[4] * rs * g1.x, kf[5] * rs * g1.y); ko.w = pk2(kf[6] * rs * g1.z, kf[7] * rs * g1.w);
            *(LAS v4u*)(Ks + jrow * KS_STRIDE + ch * 8) = ko;
            LAS bf16* vd = Vt + (ch * 8) * VT_STRIDE + jrow;
            vd[0 * VT_STRIDE] = (bf16)(vw.x & 0xffffu); vd[1 * VT_STRIDE] = (bf16)(vw.x >> 16); vd[2 * VT_STRIDE] = (bf16)(vw.y & 0xffffu); vd[3 * VT_STRIDE] = (bf16)(vw.y >> 16);
            vd[4 * VT_STRIDE] = (bf16)(vw.z & 0xffffu); vd[5 * VT_STRIDE] = (bf16)(vw.z >> 16); vd[6 * VT_STRIDE] = (bf16)(vw.w & 0xffffu); vd[7 * VT_STRIDE] = (bf16)(vw.w >> 16); }
        for (int e = tid; e < 8 * 192; e += NTHR) { const int hh = e / 192, dist = e % 192 - 32; Bs[e] = (dist >= 0 && dist < 128) ? bt[(kvh * 8 + hh) * 128 + dist] - shift * LOG2E : -1e30f; }
        __syncthreads();
        const int h = kvh * 8 + wid; const float sink2 = (sinks[h] - shift) * LOG2E;
        const LAS float* Bh = Bs + wid * 192 + (r32 - 4 * hi);
        LAS float* wsf = (LAS float*)(lds + ALDS_END) + wid * 32;
        const bf16* Qb = QKV + ((size_t)b * SEQ + nb * 128 + r32) * NQKV + h * HD + hi * 8;
        v4u qw[4];
#pragma unroll
        for (int d0 = 0; d0 < 4; ++d0) qw[d0] = *(const v4u*)(Qb + d0 * 16);
#pragma unroll 1
        for (int c = 0; c < 4; ++c) {
            bf16x8 qr[4];
            { float s = 0.f;
#pragma unroll
                for (int d0 = 0; d0 < 4; ++d0) {
                    const float f0 = bflo(qw[d0].x), f1 = bfhi(qw[d0].x), f2 = bflo(qw[d0].y), f3 = bfhi(qw[d0].y), f4 = bflo(qw[d0].z), f5 = bfhi(qw[d0].z), f6 = bflo(qw[d0].w), f7 = bfhi(qw[d0].w);
                    s += (f0 * f0 + f1 * f1) + (f2 * f2 + f3 * f3) + (f4 * f4 + f5 * f5) + (f6 * f6 + f7 * f7); }
                s = sum_x32(s);
                const float rs = __builtin_amdgcn_rsqf(s * (1.0f / 64.0f) + EPS) * (0.125f * LOG2E);
#pragma unroll
                for (int d0 = 0; d0 < 4; ++d0) { const f32x4 g0 = *(const f32x4*)(qg + d0 * 16 + hi * 8), g1 = *(const f32x4*)(qg + d0 * 16 + hi * 8 + 4);
                    v4u o; o.x = pk2(bflo(qw[d0].x) * rs * g0.x, bfhi(qw[d0].x) * rs * g0.y); o.y = pk2(bflo(qw[d0].y) * rs * g0.z, bfhi(qw[d0].y) * rs * g0.w);
                    o.z = pk2(bflo(qw[d0].z) * rs * g1.x, bfhi(qw[d0].z) * rs * g1.y); o.w = pk2(bflo(qw[d0].w) * rs * g1.z, bfhi(qw[d0].w) * rs * g1.w);
                    qr[d0] = __builtin_bit_cast(bf16x8, o); } }
            if (c < 3) {
#pragma unroll
                for (int d0 = 0; d0 < 4; ++d0) qw[d0] = *(const v4u*)(Qb + (size_t)(32 * (c + 1)) * NQKV + d0 * 16); }
            f32x16 p[5]; float l = 0.f;
#pragma unroll
            for (int kk = 0; kk < 5; ++kk) { const bool blk_ok = (nb > 0) || (c + kk >= 4);
                if (blk_ok) {
#pragma unroll
                    for (int r = 0; r < 16; ++r) p[kk][r] = Bh[160 - 32 * kk - (r & 3) - 8 * (r >> 2)];
#pragma unroll
                    for (int d0 = 0; d0 < 4; ++d0) { const bf16x8 kf = *(const LAS bf16x8*)(Ks + ((c + kk) * 32 + r32) * KS_STRIDE + d0 * 16 + hi * 8);
                        p[kk] = __builtin_amdgcn_mfma_f32_32x32x16_bf16(kf, qr[d0], p[kk], 0, 0, 0); }
                } else p[kk] = (f32x16){}; }
#pragma unroll
            for (int kk = 0; kk < 5; ++kk) { const bool blk_ok = (nb > 0) || (c + kk >= 4);
                if (blk_ok) {
#pragma unroll
                    for (int r = 0; r < 16; ++r) { const float e = __builtin_amdgcn_exp2f(p[kk][r]); p[kk][r] = e; l += e; } } }
            l = sum_x32(l); l += __builtin_amdgcn_exp2f(sink2);
            if (hi == 0) wsf[r32] = __builtin_amdgcn_rcpf(l);
            f32x16 o[2]; o[0] = (f32x16){}; o[1] = (f32x16){};
#pragma unroll
            for (int kk = 0; kk < 5; ++kk) { const bool blk_ok = (nb > 0) || (c + kk >= 4);
                if (blk_ok) {
#pragma unroll
                    for (int ks = 0; ks < 2; ++ks) { v4u pw; pw.x = pk2(p[kk][8 * ks + 0], p[kk][8 * ks + 1]); pw.y = pk2(p[kk][8 * ks + 2], p[kk][8 * ks + 3]);
                        pw.z = pk2(p[kk][8 * ks + 4], p[kk][8 * ks + 5]); pw.w = pk2(p[kk][8 * ks + 6], p[kk][8 * ks + 7]);
                        const bf16x8 pa = __builtin_bit_cast(bf16x8, pw);
#pragma unroll
                        for (int db = 0; db < 2; ++db) { const LAS bf16* vp = Vt + (db * 32 + r32) * VT_STRIDE + 32 * (c + kk) + 16 * ks + 4 * hi;
                            const v2u lo = *(const LAS v2u*)vp, hh = *(const LAS v2u*)(vp + 8); const v4u vv = (v4u){lo.x, lo.y, hh.x, hh.y};
                            o[db] = __builtin_amdgcn_mfma_f32_32x32x16_bf16(pa, __builtin_bit_cast(bf16x8, vv), o[db], 0, 0, 0); } } } }
            LDS_WAIT();
            LAS bf16* stg = (LAS bf16*)(lds + ALDS_OST) + wid * 2048;
#pragma unroll
            for (int rq = 0; rq < 4; ++rq) { const f32x4 iv = *(const LAS f32x4*)(wsf + 8 * rq + 4 * hi);
#pragma unroll
                for (int e = 0; e < 4; ++e) { const int r = 4 * rq + e, q = 8 * rq + 4 * hi + e; stg[q * 64 + r32] = (bf16)(pk2(o[0][r] * iv[e], 0.f) & 0xffffu); stg[q * 64 + 32 + r32] = (bf16)(pk2(o[1][r] * iv[e], 0.f) & 0xffffu); } }
            LDS_WAIT();
            bf16* Ow = O + ((size_t)b * SEQ + nb * 128 + 32 * c) * DM + h * HD;
#pragma unroll
            for (int i = 0; i < 4; ++i) { const int row = i * 8 + (lane >> 3), ch = lane & 7; const v4u v = *(const LAS v4u*)(stg + row * 64 + ch * 8); *(v4u*)(Ow + (size_t)row * DM + ch * 8) = v; }
        }
    }
}

template <int W> __device__ __forceinline__ void pooldiff_strip(const bf16* __restrict__ xc, bf16* __restrict__ dc, const LAS float* rsl, int pos0) {
    v2u xr[W - 1 + 32];
#pragma unroll
    for (int i = 0; i < W - 1 + 32; ++i) { const int rel = i - (W - 1); xr[i] = (pos0 + rel >= 0) ? *(const v2u*)(xc + (long)rel * DM) : (v2u){0u, 0u}; }
#define UNP(w_, r_) ((f32x4){bflo((w_).x), bfhi((w_).x), bflo((w_).y), bfhi((w_).y)} * (r_))
    f32x4 s = (f32x4){0.f, 0.f, 0.f, 0.f};
#pragma unroll
    for (int i = 0; i < W - 1; ++i) s += UNP(xr[i], rsl[16 - (W - 1) + i]);
#pragma unroll
    for (int tt = 0; tt < 32; ++tt) { const f32x4 v = UNP(xr[W - 1 + tt], rsl[16 + tt]); s += v;
        const int cnt = (pos0 + tt + 1) < W ? (pos0 + tt + 1) : W; const f32x4 dd = s * __builtin_amdgcn_rcpf((float)cnt) - v;
        v2u o; o.x = pk2(dd.x, dd.y); o.y = pk2(dd.z, dd.w); *(v2u*)(dc + (long)tt * DM) = o;
        s -= UNP(xr[tt], rsl[16 + tt - (W - 1)]); }
#undef UNP
}
__device__ __forceinline__ void pooldiff_phase(int wave_s, LAS unsigned char* lds, const bf16* x, const float* ss, bf16* d) {
    const int tid_ = tid_now(wave_s);
    const int tid = tid_; const int g = __builtin_amdgcn_readfirstlane(tid >> 7);
    LAS float* rsl = (LAS float*)lds;
    for (int strip = blockIdx.x; strip < M / 32; strip += gridDim.x) {
        const int t0 = strip * 32, pos0 = t0 & (SEQ - 1);
        __syncthreads();
        if (tid < 48 * 8) { const int rr = tid >> 3, row = t0 - 16 + rr; float s = 0.f;
            if (row >= 0) { const f32x4 v = *(const f32x4*)(ss + (size_t)row * 32 + (tid & 7) * 4); s = (v[0] + v[1]) + (v[2] + v[3]); }
            s = sum8(s);
            if ((tid & 7) == 0) rsl[rr] = __builtin_amdgcn_rsqf(s * (1.0f / 2048.0f) + EPS); }
        __syncthreads();
        const bf16* xc = x + (size_t)t0 * DM + 4 * tid; bf16* dc = d + (size_t)t0 * DM + 4 * tid;
        if (g == 0) pooldiff_strip<2>(xc, dc, rsl, pos0); else if (g == 1) pooldiff_strip<4>(xc, dc, rsl, pos0); else if (g == 2) pooldiff_strip<8>(xc, dc, rsl, pos0); else pooldiff_strip<16>(xc, dc, rsl, pos0);
    }
}

__device__ __forceinline__ void fixup_panel(int wave_s, int pm, const float* hbuf, const float* cw, const float* cb, bf16* act) {
    const int tid_ = tid_now(wave_s);
    const int tid = tid_;
    if ((pm & 31) == 0) return;
    for (int cgi = tid; cgi < DFF / 4; cgi += NTHR) { const int ch = cgi * 4;
        const int colg = 256 * (ch >> 7) + (ch & 127);
        const float* hp = hbuf + ((size_t)(pm - 1) * 4 + 2) * NUP + colg; const float* hc = hbuf + (size_t)pm * 4 * NUP + colg;
        const f32x4 gm2 = *(const f32x4*)hp, gm1 = *(const f32x4*)(hp + NUP), g0 = *(const f32x4*)hc, g1 = *(const f32x4*)(hc + NUP);
        const f32x4 vm2 = *(const f32x4*)(hp + 128), vm1 = *(const f32x4*)(hp + NUP + 128), v0 = *(const f32x4*)(hc + 128), v1 = *(const f32x4*)(hc + NUP + 128);
        const f32x4 wg0 = *(const f32x4*)(cw + ch), wg1 = *(const f32x4*)(cw + NUP + ch), wg2 = *(const f32x4*)(cw + 2 * NUP + ch), bg = *(const f32x4*)(cb + ch);
        const f32x4 wv0 = *(const f32x4*)(cw + DFF + ch), wv1 = *(const f32x4*)(cw + NUP + DFF + ch), wv2 = *(const f32x4*)(cw + 2 * NUP + DFF + ch), bv = *(const f32x4*)(cb + DFF + ch);
        const f32x4 gc0 = wg0 * gm2 + wg1 * gm1 + wg2 * g0 + bg, vc0 = wv0 * vm2 + wv1 * vm1 + wv2 * v0 + bv;
        const f32x4 gc1 = wg0 * gm1 + wg1 * g0 + wg2 * g1 + bg, vc1 = wv0 * vm1 + wv1 * v0 + wv2 * v1 + bv;
        f32x4 o0, o1;
#pragma unroll
        for (int i = 0; i < 4; ++i) { o0[i] = gc0[i] * __builtin_amdgcn_rcpf(1.0f + __builtin_amdgcn_exp2f(-gc0[i] * LOG2E)) * vc0[i]; o1[i] = gc1[i] * __builtin_amdgcn_rcpf(1.0f + __builtin_amdgcn_exp2f(-gc1[i] * LOG2E)) * vc1[i]; }
        v2u w0; w0.x = pk2(o0[0], o0[1]); w0.y = pk2(o0[2], o0[3]); v2u w1; w1.x = pk2(o1[0], o1[1]); w1.y = pk2(o1[2], o1[3]);
        *(v2u*)(act + (size_t)(256 * pm) * DFF + ch) = w0; *(v2u*)(act + (size_t)(256 * pm + 1) * DFF + ch) = w1; }
}

#ifndef REP_PRO
#define REP_PRO 1
#endif
#ifndef REP_ATTN
#define REP_ATTN 1
#endif
#ifndef REP_POOL
#define REP_POOL 1
#endif
#ifndef REP_CONV
#define REP_CONV 1
#endif
typedef const __attribute__((address_space(4))) Args* KArgs;
__device__ __forceinline__ KArgs kargs() { KArgs ap = (KArgs)__builtin_amdgcn_kernarg_segment_ptr(); asm volatile("" : "+s"(ap)); return ap; }
#define WSP(T, off) ((T*)(ap->ws + (off)))
#define XB_TMO      128
#define XB_XCNT(j)  (256  + 64 * (j))
#define XB_XSUB(j)  (1280 + 64 * (j))
#define XB_XGEN(j)  (2304 + 64 * (j))
#define XB_TOP      3328
#define XB_TOPGEN   3392
#define XCD_BAR_WORDS 3456
#define XB_SPIN_CAP (1u << 20)
constexpr int XB_LDS_OFF = 131072 + 8192;
__device__ __forceinline__ unsigned xb_ld(unsigned* p)              { return __hip_atomic_load(p, __ATOMIC_RELAXED, __HIP_MEMORY_SCOPE_AGENT); }
__device__ __forceinline__ unsigned xb_add(unsigned* p, unsigned v) { return __hip_atomic_fetch_add(p, v, __ATOMIC_RELAXED, __HIP_MEMORY_SCOPE_AGENT); }
__device__ __forceinline__ unsigned xb_xcc_id() { return (unsigned)__builtin_amdgcn_s_getreg((3 << 11) | 20) & 0xFu; }
#define XB_SPIN(cond, bar) do { unsigned _sp = 0; while (cond) { __builtin_amdgcn_s_sleep(1); \
    if ((++_sp & 255u) == 0u) { if (xb_ld(&(bar)[XB_TMO])) break; if (_sp > XB_SPIN_CAP) { atomicAdd(&(bar)[XB_TMO], 1u); break; } } } } while (0)
__device__ __forceinline__ void xcd_barrier_complete(unsigned* bar, unsigned x, unsigned& nloc, unsigned& nx) {
    const unsigned G = gridDim.x * gridDim.y * gridDim.z;
    unsigned sum, cnt, mine, sp = 0u;
    for (;;) {
        sum = 0u; cnt = 0u; mine = 0u;
#pragma unroll
        for (unsigned j = 0; j < 16; ++j) { const unsigned c = xb_ld(&bar[XB_XCNT(j)]); sum += c; cnt += (c > 0u) ? 1u : 0u; mine = (j == x) ? c : mine; }
        if (sum == G) break;
        __builtin_amdgcn_s_sleep(1);
        if ((++sp & 255u) == 0u) { if (xb_ld(&bar[XB_TMO])) break; if (sp > XB_SPIN_CAP) { atomicAdd(&bar[XB_TMO], 1u); break; } }
    }
    nloc = mine > 0u ? mine : 1u; nx = cnt > 0u ? cnt : 1u;
}
__device__ __forceinline__ void grid_bar(int wave_s) {
    asm volatile("s_waitcnt vmcnt(0)" ::: "memory");
    __syncthreads();
    if (tid_now(wave_s) == 0) {
        KArgs ap = kargs(); unsigned* bar = WSP(unsigned, WS_BAR);
        extern __shared__ __attribute__((aligned(16))) unsigned char lds_raw_[];
        volatile LAS unsigned* st = (volatile LAS unsigned*)((LAS unsigned char*)lds_raw_ + XB_LDS_OFF);
        const unsigned x = xb_xcc_id();
        __builtin_amdgcn_s_waitcnt(0);
        unsigned nloc = st[0], nx = st[1];
        if (nloc == 0u) { xcd_barrier_complete(bar, x, nloc, nx); st[0] = nloc; st[1] = nx; }
        const unsigned old = xb_add(&bar[XB_XSUB(x)], 1u);
        const unsigned gen = old / nloc;
        if (old + 1u == (gen + 1u) * nloc) {
            __builtin_amdgcn_fence(__ATOMIC_RELEASE, "agent");
            asm volatile("s_waitcnt vmcnt(0)" ::: "memory");
            const unsigned og = xb_add(&bar[XB_TOP], 1u);
            const unsigned tg = og / nx;
            if (og + 1u == (tg + 1u) * nx) xb_add(&bar[XB_TOPGEN], 1u);
            else XB_SPIN(xb_ld(&bar[XB_TOPGEN]) == tg, bar);
            __builtin_amdgcn_fence(__ATOMIC_ACQUIRE, "agent");
            xb_add(&bar[XB_XGEN(x)], 1u);
            asm volatile("s_waitcnt vmcnt(0)" ::: "memory");
        } else {
            XB_SPIN(xb_ld(&bar[XB_XGEN(x)]) == gen, bar);
            __builtin_amdgcn_fence(__ATOMIC_ACQUIRE, "agent");
            asm volatile("s_waitcnt vmcnt(0)" ::: "memory");
        }
    }
    __syncthreads();
}
__global__ void __launch_bounds__(NTHR, 2) fwd_kernel(Args a_in) {
    extern __shared__ __attribute__((aligned(16))) unsigned char lds_raw[];
    LAS unsigned char* lds = (LAS unsigned char*)lds_raw;
    cg::grid_group grid = cg::this_grid();
    if (threadIdx.x == 0) { volatile LAS unsigned* st = (volatile LAS unsigned*)(lds + XB_LDS_OFF); st[0] = 0u; st[1] = 0u; const unsigned x_ = xb_xcc_id(); st[2] = x_; st[3] = xb_add((unsigned*)(a_in.ws + WS_BAR) + XB_XCNT(x_), 1u); }
    for (int rp_ = 0; rp_ < REP_PRO; ++rp_) prologue_phase(a_in, lds);
    const int wave_s = __builtin_amdgcn_readfirstlane(threadIdx.x >> 6);
    if (gridDim.x == 0x7fffffffu) grid.sync();
    grid_bar(wave_s);
    if (threadIdx.x == 0) { volatile LAS unsigned* st = (volatile LAS unsigned*)(lds + XB_LDS_OFF); unsigned* bw = (unsigned*)(a_in.ws + WS_BAR); bool ok = gridDim.x == 256;
        for (int j = 0; j < 16; ++j) { const unsigned c_ = xb_ld(bw + XB_XCNT(j)); ok = ok && (c_ == (j < 8 ? 32u : 0u)); }
        st[4] = ok ? (st[2] + 8u * st[3]) : (unsigned)blockIdx.x; }
    __syncthreads();
    const int cu_idx = __builtin_amdgcn_readfirstlane((int)((volatile LAS unsigned*)(lds + XB_LDS_OFF))[4]);

    for (int layer = 0; layer < DEPTH; ++layer) {
        const int j = layer >> 1;
        if ((layer & 1) == 0) {
            { KArgs ap = kargs(); const int G = gridDim.x, bx = cu_idx;
              pg8::Gemm g{WSP(bf16, WS_XB), WSP(const bf16, WS_WQKV) + (size_t)j * NQKV * DM, DM, DM, DM, 1 << 20}; pg8::StaticOrder S; S.init(M, NQKV, G, bx);
              pg8::EpiScaleBf16 E{WSP(bf16, WS_QKV), NQKV, WSP(float, WS_SS) + (size_t)(2 * layer) * M * 32, lds};
              pg8::gemm_phase<pg8::EpiScaleBf16, pg8::StaticOrder, true, true>(lds, g, S, E, wave_s); }
            grid_bar(wave_s);
            { KArgs ap = kargs();
              for (int rp_ = 0; rp_ < REP_ATTN; ++rp_) attn_phase(wave_s, lds, WSP(bf16, WS_QKV), WSP(bf16, WS_OB), ap->in[I_QG] + j * HD, ap->in[I_KG] + j * HD, ap->in[I_SINK] + j * NH, WSP(const float, WS_BT)); }
            grid_bar(wave_s);
            { KArgs ap = kargs(); const int G = gridDim.x, bx = cu_idx;
              pg8::Gemm g{WSP(bf16, WS_OB), WSP(const bf16, WS_WO) + (size_t)j * DM * DM, DM, DM, DM, 1 << 20}; pg8::StaticOrder S; S.init(M, DM, G, bx);
              pg8::EpiResidual E{WSP(bf16, WS_XB), nullptr, nullptr, WSP(float, WS_SS) + (size_t)(2 * layer + 1) * M * 32};
              pg8::gemm_phase<pg8::EpiResidual, pg8::StaticOrder, true, true>(lds, g, S, E, wave_s); }
            grid_bar(wave_s);
        } else {
            { KArgs ap = kargs();
              for (int rp_ = 0; rp_ < REP_POOL; ++rp_) pooldiff_phase(wave_s, lds, WSP(bf16, WS_XB), WSP(float, WS_SS) + (size_t)(2 * layer) * M * 32, WSP(bf16, WS_QKV)); }
            grid_bar(wave_s);
            { KArgs ap = kargs(); const int G = gridDim.x, bx = cu_idx;
              pg8::Gemm g{WSP(bf16, WS_QKV), WSP(const bf16, WS_WPL) + (size_t)j * DM * PG, DM, PG, PG, 2}; pg8::StaticOrder S; S.init(M, DM, G, bx);
              pg8::EpiResidual E{WSP(bf16, WS_XB), nullptr, ap->in[I_PS] + j * DM, WSP(float, WS_SS) + (size_t)(2 * layer + 1) * M * 32};
              pg8::gemm_phase<pg8::EpiResidual, pg8::StaticOrder, true, true>(lds, g, S, E, wave_s); }
            grid_bar(wave_s);
        }
        { KArgs ap = kargs(); const int G = gridDim.x, bx = cu_idx;
          pg8::Gemm g{WSP(bf16, WS_XB), WSP(const bf16, WS_WUP) + (size_t)layer * NUP * DM, DM, DM, DM, 1 << 20}; pg8::StaticOrder S; S.init(M, NUP, G, bx);
          pg8::EpiConvAct E{WSP(bf16, WS_ACT), WSP(float, WS_SS) + (size_t)(2 * layer + 1) * M * 32, ap->in[I_CW] + (size_t)layer * 3 * NUP, ap->in[I_CB] + (size_t)layer * NUP, WSP(float, WS_HB), lds};
          pg8::gemm_phase<pg8::EpiConvAct, pg8::StaticOrder, true, true>(lds, g, S, E, wave_s); }
        grid_bar(wave_s);
        { KArgs ap = kargs(); const int G = gridDim.x, bx = cu_idx;
          pg8::Gemm g{WSP(bf16, WS_ACT), WSP(const bf16, WS_WDN) + (size_t)layer * DM * DFF, DFF, DFF, DFF, 1 << 20}; pg8::StaticOrder S; S.init(M, DM, G, bx);
          { pg8::Unit u0; if (S.next(0, u0)) fixup_panel(wave_s, u0.pm, WSP(float, WS_HB), ap->in[I_CW] + (size_t)layer * 3 * NUP, ap->in[I_CB] + (size_t)layer * NUP, WSP(bf16, WS_ACT));
            asm volatile("s_waitcnt vmcnt(0)" ::: "memory"); __syncthreads(); }
          pg8::EpiResidual E{WSP(bf16, WS_XB), (layer == DEPTH - 1) ? ap->out : nullptr, nullptr, WSP(float, WS_SS) + (size_t)(2 * layer + 2) * M * 32};
          pg8::gemm_phase<pg8::EpiResidual, pg8::StaticOrder, true, true>(lds, g, S, E, wave_s); }
        if (layer + 1 < DEPTH) grid_bar(wave_s);
    }
}

extern "C" void kernel_launch(void* const* d_in, const int* in_sizes, int n_in, void* d_out, int out_size, void* d_ws, size_t ws_size, hipStream_t stream) {
    static int grid = 0;
    if (grid == 0) {
        if (n_in != 15 || out_size != M * DM || ws_size < WS_END) { fprintf(stderr, "kernel_launch: unexpected shapes (n_in %d out %d ws %zu need %zu)\n", n_in, out_size, ws_size, (size_t)WS_END); grid = -1; return; }
        int dev = 0, cus = 0, per_cu = 0;
        hipGetDevice(&dev); hipDeviceGetAttribute(&cus, hipDeviceAttributeMultiprocessorCount, dev);
        hipFuncSetAttribute((const void*)fwd_kernel, hipFuncAttributeMaxDynamicSharedMemorySize, LDS_BYTES);
        hipOccupancyMaxActiveBlocksPerMultiprocessor(&per_cu, (const void*)fwd_kernel, NTHR, LDS_BYTES);
        if (per_cu < 1) per_cu = 1;
        (void)hipGetLastError();
        grid = cus * per_cu;
        if (grid > 256) grid = 256;
        if (grid != 256) { fprintf(stderr, "kernel_launch: needs 256 co-resident workgroups, device offers %d\n", grid); grid = -1; return; }
    }
    if (grid < 0) return;
    if (hipMemsetAsync((char*)d_ws + WS_BAR, 0, 16384, stream) != hipSuccess) { fprintf(stderr, "kernel_launch: memset failed\n"); return; }
    Args a{};
    for (int i = 0; i < 15; ++i) a.in[i] = (const float*)d_in[i];
    a.out = (float*)d_out; a.ws = (unsigned char*)d_ws;
    void* args[] = {&a};
    hipError_t e = hipLaunchCooperativeKernel((const void*)fwd_kernel, dim3(grid), dim3(NTHR), args, LDS_BYTES, stream);
    if (e != hipSuccess) fprintf(stderr, "cooperative launch failed: %s (grid %d)\n", hipGetErrorString(e), grid);
}
```
